# Optimizing an MI355X kernel written in HIP

```python
import math
import jax
import jax.numpy as jnp
from jax import lax
import numpy as np

D_MODEL = 1024
BATCH = 4
SEQ = 4096
DEPTH = 2

PLE_DIM = 256
N_EVEN = (DEPTH + 1) // 2
N_ODD = DEPTH // 2

DA_HEADS = 4
DA_HEAD_DIM = 64
DA_V_DIM = 2 * DA_HEAD_DIM
DA_QK_WIDTH = DA_HEADS * 2 * DA_HEAD_DIM
DA_WIDTH = DA_HEADS * DA_V_DIM
ROPE_THETA = 500000.0
ROT_DIM = DA_HEAD_DIM // 4
Q_BLOCK = 128

SC_WIDTH = 512
SC_WIDTH_CONV = 3
EVEN_IN_WIDTH = 3 * DA_QK_WIDTH // 2 * 2 // 2 * 0 + DA_QK_WIDTH * 2 + DA_WIDTH + 3 * SC_WIDTH

GM_WIDTH = D_MODEL
GM_GROUPS = 8
GM_GROUP_CH = GM_WIDTH // GM_GROUPS
GM_CHUNK = 128

D_FF = 2816
N_EXPERTS = 8
TOP_K = 2
MOE_BLOCK = 256

RMS_EPS = 1e-6
LN_EPS = 1e-5

kernel_name = "hybrid_diffattn_shortconv_gmlp_moe_ple"


def rms_norm(x, g):
    xf = x.astype(jnp.float32)
    y = xf * lax.rsqrt(jnp.mean(xf * xf, axis=-1, keepdims=True) + RMS_EPS)
    return (y * g.astype(jnp.float32)).astype(x.dtype)


def layer_norm(x, g, b):
    xf = x.astype(jnp.float32)
    mu = jnp.mean(xf, axis=-1, keepdims=True)
    var = jnp.mean(jnp.square(xf - mu), axis=-1, keepdims=True)
    y = (xf - mu) * lax.rsqrt(var + LN_EPS)
    return (y * g.astype(jnp.float32) + b.astype(jnp.float32)).astype(x.dtype)


def rope_partial(t, positions):
    half = ROT_DIM // 2
    inv_freq = ROPE_THETA ** (-jnp.arange(0, ROT_DIM, 2, dtype=jnp.float32) / ROT_DIM)
    ang = positions.astype(jnp.float32)[:, :, None] * inv_freq
    cos = jnp.cos(ang)[:, :, None, None, :].astype(t.dtype)
    sin = jnp.sin(ang)[:, :, None, None, :].astype(t.dtype)
    t1 = t[..., :half]
    t2 = t[..., half:ROT_DIM]
    return jnp.concatenate([t1 * cos - t2 * sin, t2 * cos + t1 * sin, t[..., ROT_DIM:]], axis=-1)


def diff_attention(q, k, v, lam, lambda_init, subln_g):
    bsz, seq = q.shape[0], q.shape[1]
    n_blocks = seq // Q_BLOCK
    q = q * (DA_HEAD_DIM ** -0.5)
    kpos = jnp.arange(seq)

    def one_block(i):
        qb = lax.dynamic_slice_in_dim(q, i * Q_BLOCK, Q_BLOCK, axis=1)
        s = jnp.einsum('bqhcd,bkhcd->bhcqk', qb, k, preferred_element_type=jnp.float32)
        qpos = i * Q_BLOCK + jnp.arange(Q_BLOCK)
        mask = kpos[None, :] <= qpos[:, None]
        pr = jax.nn.softmax(jnp.where(mask, s, -jnp.inf), axis=-1)
        w = pr[:, :, 0] - lam * pr[:, :, 1]
        return jnp.einsum('bhqk,bkhe->bqhe', w.astype(v.dtype), v)

    out = lax.map(one_block, jnp.arange(n_blocks))
    out = jnp.moveaxis(out, 0, 1).reshape(bsz, seq, DA_HEADS, DA_V_DIM)
    out = rms_norm(out, subln_g) * (1.0 - lambda_init)
    return out.reshape(bsz, seq, DA_WIDTH)


def causal_short_conv(z, w):
    ch = z.shape[-1]
    rhs = jnp.transpose(w).astype(z.dtype)[:, None, :]
    return lax.conv_general_dilated(z, rhs, window_strides=(1,), padding=[(SC_WIDTH_CONV - 1, 0)],
                                    dimension_numbers=('NWC', 'WIO', 'NWC'), feature_group_count=ch)


def spatial_gating(u, v, w_s, b_s):
    bsz, seq, _ = v.shape
    vr = v.reshape(bsz, seq // GM_CHUNK, GM_CHUNK, GM_GROUPS, GM_GROUP_CH)
    tril = jnp.tril(jnp.ones((GM_CHUNK, GM_CHUNK), dtype=w_s.dtype))
    vs = jnp.einsum('gts,bnsgc->bntgc', w_s * tril, vr)
    vs = vs + jnp.transpose(b_s)[None, None, :, :, None]
    return u * vs.reshape(bsz, seq, GM_WIDTH)


def swiglu(h, w1, w3, w2):
    return (jax.nn.silu(h @ w1) * (h @ w3)) @ w2


def moe_swiglu(h, router_w, w1, w3, w2):
    bsz, seq, dm = h.shape
    n_tok = bsz * seq
    n_assign = n_tok * TOP_K
    n_blocks = -(-(n_assign + N_EXPERTS * (MOE_BLOCK - 1)) // MOE_BLOCK)
    xt = h.reshape(n_tok, dm)
    logits = jnp.einsum('nd,de->ne', xt, router_w, preferred_element_type=jnp.float32)
    top_val, top_idx = lax.top_k(logits, TOP_K)
    gates = jax.nn.softmax(top_val, axis=-1)
    expert_flat = top_idx.reshape(-1)
    token_flat = jnp.arange(n_assign) // TOP_K
    gate_flat = gates.reshape(-1)
    order = jnp.argsort(expert_flat)
    sorted_expert = expert_flat[order]
    sorted_token = token_flat[order]
    counts = jnp.bincount(expert_flat, length=N_EXPERTS)
    starts = jnp.cumsum(counts) - counts
    padded = (counts + MOE_BLOCK - 1) // MOE_BLOCK * MOE_BLOCK
    pad_ends = jnp.cumsum(padded)
    pad_starts = pad_ends - padded
    dest = pad_starts[sorted_expert] + (jnp.arange(n_assign) - starts[sorted_expert])
    rows = jnp.zeros((n_blocks * MOE_BLOCK, dm), h.dtype).at[dest].set(xt[sorted_token])
    block_start = jnp.arange(n_blocks) * MOE_BLOCK
    block_expert = jnp.minimum(jnp.searchsorted(pad_ends, block_start, side='right'), N_EXPERTS - 1)

    def expert_block(args):
        xb, e = args
        return (jax.nn.silu(xb @ w1[e]) * (xb @ w3[e])) @ w2[e]

    y_rows = lax.map(expert_block, (rows.reshape(n_blocks, MOE_BLOCK, dm), block_expert))
    y_sorted = y_rows.reshape(n_blocks * MOE_BLOCK, dm)[dest]
    contrib = y_sorted * gate_flat[order][:, None].astype(h.dtype)
    out = jax.ops.segment_sum(contrib, sorted_token, num_segments=n_tok)
    return out.reshape(bsz, seq, dm)


def setup_inputs(seed: int = 0) -> dict:
    key = jax.random.key(seed)
    ks = list(jax.random.split(key, 40))
    cnt = [0]

    def nk():
        cnt[0] += 1
        return ks[cnt[0] - 1]

    def nrm(shape, scale):
        return scale * jax.random.normal(nk(), shape, jnp.float32)

    def gain(shape):
        return 1.0 + nrm(shape, 0.05)

    x = nrm((BATCH, SEQ, D_MODEL), 1.0)
    p = nrm((DEPTH, BATCH, SEQ, PLE_DIM), 1.0)
    positions = (jax.random.randint(nk(), (BATCH, 1), 0, 1024, jnp.int32)
                 + jnp.arange(SEQ, dtype=jnp.int32)[None, :])
    dsc = D_MODEL ** -0.5
    return {
        "x": x,
        "p": p,
        "positions": positions,
        "ln_mix": gain((DEPTH, D_MODEL)),
        "ln_ffn": gain((DEPTH, D_MODEL)),
        "ln_ple": gain((DEPTH, D_MODEL)),
        "a_w_in": nrm((N_EVEN, D_MODEL, EVEN_IN_WIDTH), dsc),
        "a_lambda": nrm((N_EVEN, 4, DA_HEAD_DIM), 0.1),
        "a_subln": gain((N_EVEN, DA_V_DIM)),
        "a_conv_w": nrm((N_EVEN, SC_WIDTH, SC_WIDTH_CONV), SC_WIDTH_CONV ** -0.5),
        "a_w_out": nrm((N_EVEN, DA_WIDTH + SC_WIDTH, D_MODEL), (DA_WIDTH + SC_WIDTH) ** -0.5),
        "ffn_w1": nrm((N_EVEN, D_MODEL, D_FF), dsc),
        "ffn_w3": nrm((N_EVEN, D_MODEL, D_FF), dsc),
        "ffn_w2": nrm((N_EVEN, D_FF, D_MODEL), D_FF ** -0.5),
        "c_w_in": nrm((N_ODD, D_MODEL, 2 * GM_WIDTH), dsc),
        "c_ln_g": gain((N_ODD, GM_WIDTH)),
        "c_ln_b": nrm((N_ODD, GM_WIDTH), 0.02),
        "c_w_s": nrm((N_ODD, GM_GROUPS, GM_CHUNK, GM_CHUNK), GM_CHUNK ** -0.5),
        "c_b_s": 1.0 + nrm((N_ODD, GM_GROUPS, GM_CHUNK), 0.1),
        "c_w_out": nrm((N_ODD, GM_WIDTH, D_MODEL), GM_WIDTH ** -0.5),
        "router_w": nrm((N_ODD, D_MODEL, N_EXPERTS), dsc),
        "moe_w1": nrm((N_ODD, N_EXPERTS, D_MODEL, D_FF), dsc),
        "moe_w3": nrm((N_ODD, N_EXPERTS, D_MODEL, D_FF), dsc),
        "moe_w2": nrm((N_ODD, N_EXPERTS, D_FF, D_MODEL), D_FF ** -0.5),
        "ple_gate": nrm((DEPTH, D_MODEL, D_MODEL), dsc),
        "ple_proj": nrm((DEPTH, PLE_DIM, D_MODEL), PLE_DIM ** -0.5),
        "final_norm": gain((D_MODEL,)),
    }


def reference(x, p, positions, ln_mix, ln_ffn, ln_ple, a_w_in, a_lambda, a_subln, a_conv_w,
              a_w_out, ffn_w1, ffn_w3, ffn_w2, c_w_in, c_ln_g, c_ln_b, c_w_s, c_b_s, c_w_out,
              router_w, moe_w1, moe_w3, moe_w2, ple_gate, ple_proj, final_norm):
    h = x
    bsz, seq, _ = x.shape
    splits = [DA_QK_WIDTH, 2 * DA_QK_WIDTH, 2 * DA_QK_WIDTH + DA_WIDTH,
              2 * DA_QK_WIDTH + DA_WIDTH + SC_WIDTH, 2 * DA_QK_WIDTH + DA_WIDTH + 2 * SC_WIDTH]
    for i in range(DEPTH):
        j = i // 2
        hn = rms_norm(h, ln_mix[i])
        if i % 2 == 0:
            z = hn @ a_w_in[j]
            q, k, v, b_gate, c_gate, hc = jnp.split(z, splits, axis=-1)
            q = rope_partial(q.reshape(bsz, seq, DA_HEADS, 2, DA_HEAD_DIM), positions)
            k = rope_partial(k.reshape(bsz, seq, DA_HEADS, 2, DA_HEAD_DIM), positions)
            v = v.reshape(bsz, seq, DA_HEADS, DA_V_DIM)
            lambda_init = 0.8 - 0.6 * math.exp(-0.3 * i)
            lp = a_lambda[j].astype(jnp.float32)
            lam = jnp.exp(jnp.sum(lp[0] * lp[1])) - jnp.exp(jnp.sum(lp[2] * lp[3])) + lambda_init
            attn = diff_attention(q, k, v, lam, lambda_init, a_subln[j])
            conv = b_gate * causal_short_conv(c_gate * hc, a_conv_w[j])
            h = h + jnp.concatenate([attn, conv], axis=-1) @ a_w_out[j]
            h = h + swiglu(rms_norm(h, ln_ffn[i]), ffn_w1[j], ffn_w3[j], ffn_w2[j])
        else:
            z = jax.nn.gelu(hn @ c_w_in[j], approximate=False)
            u, vv = jnp.split(z, 2, axis=-1)
            vv = layer_norm(vv, c_ln_g[j], c_ln_b[j])
            h = h + spatial_gating(u, vv, c_w_s[j], c_b_s[j]) @ c_w_out[j]
            h = h + moe_swiglu(rms_norm(h, ln_ffn[i]), router_w[j], moe_w1[j], moe_w3[j], moe_w2[j])
        gate = jax.nn.sigmoid(rms_norm(h, ln_ple[i]) @ ple_gate[i])
        h = h + gate * (p[i] @ ple_proj[i])
    return rms_norm(h, final_norm)
```

```cpp
#include <hip/hip_runtime.h>
#include <hip/hip_bf16.h>
#include <cstdio>
#include <cstdint>
#include <cmath>

#ifndef MK_N_LAUNCHES
#define MK_N_LAUNCHES 1
#endif
#define NV_GEMM   1u
#define NV_ATTN   2u
#define NV_SGATE  4u
#ifndef NAIVE_MASK
#define NAIVE_MASK (NV_SGATE)
#endif

#define GAS __attribute__((address_space(1)))
#define LAS __attribute__((address_space(3)))
typedef unsigned short bf16;
typedef unsigned v4u __attribute__((ext_vector_type(4)));
typedef unsigned v2u __attribute__((ext_vector_type(2)));
typedef float f32x4 __attribute__((ext_vector_type(4)));
typedef float f32x2 __attribute__((ext_vector_type(2)));
typedef short bf16x8 __attribute__((ext_vector_type(8)));
typedef GAS unsigned gu32;
#define RLX_AGENT __ATOMIC_RELAXED, __HIP_MEMORY_SCOPE_AGENT
#define LDS_WAIT() asm volatile("s_waitcnt lgkmcnt(0)" ::: "memory")
#define VM_WAIT() asm volatile("s_waitcnt vmcnt(0)" ::: "memory")

constexpr int BATCH = 4, SEQ = 4096, NTOK = BATCH * SEQ, DM = 1024, PLE = 256, DFF = 2816, NE = 8, ZW = 3072;
constexpr int NWAVES = 8, NTHREADS = 512;
constexpr float RMS_EPS = 1e-6f, LN_EPS = 1e-5f;
constexpr float ATT_C2 = 0.125f * 1.4426950408889634f;

constexpr size_t MiB = 1u << 20;
constexpr size_t WS_CTL = 0, CTL_ZERO_BYTES = 1 * MiB;
constexpr size_t WS_TAB = 1 * MiB;
constexpr size_t WS_SSA = 2 * MiB, WS_SSB = 3 * MiB;
constexpr size_t WS_LNS = 4 * MiB, WS_LNQ = 5 * MiB;
constexpr size_t WS_MTOK = 6 * MiB;
constexpr size_t WS_MSCL = WS_MTOK + 512 * 1024;
constexpr size_t WS_MGATE = 7 * MiB;
constexpr size_t WS_MSLOT = WS_MGATE + 512 * 1024;
constexpr size_t WS_WTRIL = WS_MSLOT + 128 * 1024;
constexpr size_t WS_W = 8 * MiB;
constexpr size_t WS_WIN0 = WS_W;
constexpr size_t WS_WOUT0 = WS_WIN0 + (size_t)ZW * DM * 2;
constexpr size_t WS_W13_0 = WS_WOUT0 + (size_t)DM * DM * 2;
constexpr size_t WS_W2_0 = WS_W13_0 + (size_t)2 * DFF * DM * 2;
constexpr size_t WS_WCIN = WS_W2_0 + (size_t)DM * DFF * 2;
constexpr size_t WS_WCOUT = WS_WCIN + (size_t)2 * DM * DM * 2;
constexpr size_t WS_PLEG = WS_WCOUT + (size_t)DM * DM * 2;
constexpr size_t WS_PLEP = WS_PLEG + (size_t)2 * DM * DM * 2;
constexpr size_t WS_M13 = WS_PLEP + (size_t)2 * DM * PLE * 2;
constexpr size_t WS_M2 = WS_M13 + (size_t)NE * 2 * DFF * DM * 2;
constexpr size_t WS_WEND = WS_M2 + (size_t)NE * DM * DFF * 2;
constexpr size_t WS_HB = 176 * MiB;
constexpr size_t WS_PP = 208 * MiB;
constexpr size_t WS_Y = 176 * MiB;
constexpr size_t WS_BIG = 240 * MiB;
constexpr size_t WS_Z = WS_BIG;
constexpr size_t WS_AO = WS_BIG + 96 * MiB;
constexpr size_t WS_AT = WS_BIG + 128 * MiB;
constexpr size_t WS_ACT0 = WS_BIG;
constexpr size_t WS_UV = WS_BIG;
constexpr size_t WS_SG = WS_BIG + 64 * MiB;
constexpr size_t WS_ACTM = WS_BIG;
constexpr size_t WS_HB2 = WS_BIG;
constexpr size_t WS_HB3 = WS_BIG + 96 * MiB;
constexpr size_t WS_PP2 = WS_BIG + 32 * MiB;
constexpr size_t WS_PB1 = 418 * MiB;
constexpr size_t WS_END = 426 * MiB;
static_assert(WS_WEND <= WS_HB, "weights fit below HB");
static_assert(WS_ACTM + (size_t)(32768 + 256) * DFF * 2 <= WS_PB1, "ACTM fits");
constexpr int CW_BAR = 4096;
constexpr int CW_CNT = 8192;

__device__ __forceinline__ int fresh_lane() { int x; asm volatile("v_mbcnt_lo_u32_b32 %0, -1, 0\n\tv_mbcnt_hi_u32_b32 %0, -1, %0" : "=v"(x)); return x; }
__device__ __forceinline__ float bf2f(bf16 b) { return __builtin_bit_cast(float, (unsigned)b << 16); }
__device__ __forceinline__ float bflo(unsigned w) { return __builtin_bit_cast(float, w << 16); }
__device__ __forceinline__ float bfhi(unsigned w) { return __builtin_bit_cast(float, w & 0xffff0000u); }
typedef __bf16 bf16x2_t __attribute__((ext_vector_type(2)));
__device__ __forceinline__ unsigned pk2(float lo, float hi) { f32x2 v = {lo, hi}; bf16x2_t b = __builtin_convertvector(v, bf16x2_t); return __builtin_bit_cast(unsigned, b); }
__device__ __forceinline__ v4u pk8(const float (&v)[8]) { v4u w; w.x = pk2(v[0], v[1]); w.y = pk2(v[2], v[3]); w.z = pk2(v[4], v[5]); w.w = pk2(v[6], v[7]); return w; }
__device__ __forceinline__ void unpk8(v4u w, float (&v)[8]) { v[0] = bflo(w.x); v[1] = bfhi(w.x); v[2] = bflo(w.y); v[3] = bfhi(w.y); v[4] = bflo(w.z); v[5] = bfhi(w.z); v[6] = bflo(w.w); v[7] = bfhi(w.w); }
__device__ __forceinline__ float wave_sum(float v) {
#pragma unroll
    for (int o = 1; o < 64; o <<= 1) v += __shfl_xor(v, o);
    return v;
}
__device__ __forceinline__ float rscale16(const float* ss, int row) {
    const f32x4* p = (const f32x4*)(ss + (size_t)row * 16);
    const f32x4 a = p[0], b = p[1], c = p[2], d = p[3];
    const float s = ((a.x + a.y) + (a.z + a.w)) + ((b.x + b.y) + (b.z + b.w)) + ((c.x + c.y) + (c.z + c.w)) + ((d.x + d.y) + (d.z + d.w));
    return 1.0f / sqrtf(s * (1.0f / DM) + RMS_EPS);
}
__device__ __forceinline__ float sum16(const float* p16) {
    const f32x4* p = (const f32x4*)p16; const f32x4 a = p[0], b = p[1], c = p[2], d = p[3];
    return ((a.x + a.y) + (a.z + a.w)) + ((b.x + b.y) + (b.z + b.w)) + ((c.x + c.y) + (c.z + c.w)) + ((d.x + d.y) + (d.z + d.w));
}
__device__ __forceinline__ float sigmoidf_(float x) { return 1.0f / (1.0f + __expf(-x)); }
__device__ __forceinline__ float siluf_(float x) { return x / (1.0f + __expf(-x)); }
__device__ __forceinline__ float geluf_(float v) {
    const float av = fabsf(v), t = __builtin_amdgcn_rcpf(av * 0.2316418882f + 1.0f);
    float q = t * 0.5307027145f + (-0.7265760135f); q = q * t + 0.7107068705f; q = q * t + (-0.142248368f); q = q * t + 0.127414796f; q = q * t;
    const float e = __builtin_amdgcn_exp2f((v * v) * (-0.72134752044f));
    const float m = v * (q * e);
    return v < 0.f ? m : v - m;
}
namespace pg8 {
constexpr int BM = 256, BK = 64, HALF = 128, HTB = HALF * BK * 2  , STAGE_BYTES = 8 * HTB, NXCD = 8, WGM = 8;

__host__ __device__ __forceinline__ int lds_byte(int r, int c) { const int st = (r >> 4) * 2 + (c >> 5), rr = r & 15, cc = c & 31, ob = rr * 64 + cc * 2; return st * 1024 + (ob ^ (((ob >> 9) & 1) << 5)); }
__host__ __device__ __forceinline__ void stage_rc(int b, int& R, int& C) { const int st = b / 1024, sb = b % 1024, swz = sb ^ (((sb >> 9) & 1) << 5); R = (st >> 1) * 16 + swz / 64; C = (st & 1) * 32 + (swz % 64) / 2; }
__host__ __device__ __forceinline__ int perm32(int rho) { const int n = rho >> 4, i = rho & 15; return 8 * (i >> 2) + 4 * n + (i & 3); }

struct Unit { int row0, col0, e, valid, pos0; };
struct Gemm { const bf16* A; const bf16* Bt; size_t bstride; int K; const int* tok; };

struct StaticOrder {
    int nM, nN, nwg, G, c;
    __device__ void init(int M, int N, int G_, int c_) { nM = M / BM; nN = N / BM; nwg = nM * nN; G = G_; c = c_; }
    __device__ __forceinline__ bool tile(int i, int& pm, int& pn) const {
        const long L = (long)i * G + c; if (L >= nwg) return false;
        int wgid = (int)L; { const int q = nwg / NXCD, r = nwg % NXCD, xcd = wgid % NXCD, off = wgid / NXCD; wgid = (xcd < r ? xcd * (q + 1) : r * (q + 1) + (xcd - r) * q) + off; }
        const int nig = WGM * nN, gid = wgid / nig, fm = gid * WGM, gsz = (nM - fm) < WGM ? (nM - fm) : WGM;
        pm = fm + ((wgid % nig) % gsz); pn = (wgid % nig) / gsz; return true;
    }
    __device__ __forceinline__ bool next(int i, Unit& u) const { int pm, pn; if (!tile(i, pm, pn)) return false; u.row0 = pm * BM; u.col0 = pn * BM; u.e = 0; u.valid = BM; u.pos0 = 0; return true; }
};
struct MoeOrder {
    StaticOrder so; const LAS int* tab;
    __device__ void init(const LAS int* tab_, int N, int G_, int c_) { tab = tab_; so.nM = tab_[8]; so.nN = N / BM; so.nwg = so.nM * so.nN; so.G = G_; so.c = c_; }
    __device__ __forceinline__ bool next(int i, Unit& u) const {
        int gm, pn; if (!so.tile(i, gm, pn)) return false;
        int e = 0;
#pragma unroll
        for (int k = 1; k < 8; ++k) e += (gm >= tab[k]) ? 1 : 0;
        const int j = gm - tab[e], cnt = tab[18 + e];
        u.e = e; u.pos0 = j * BM; u.row0 = tab[9 + e] + j * BM; u.col0 = pn * BM; u.valid = (cnt - j * BM) < BM ? (cnt - j * BM) : BM; return true;
    }
};

template <class Epi, class Sched, bool GATHER, bool ALIGN_EPI>
__device__ __forceinline__ void gemm_phase(LAS unsigned char* lds, const int wid, const Gemm g, const Sched& S, const Epi& E) {
    const int lane = fresh_lane(), tid = (wid << 6) | lane, wr = wid >> 2, wc = wid & 3, fr = lane & 15, fq = lane >> 4;
    const int K = g.K, nt = K / BK;
    int RA[2], CA[2]; unsigned voffB[2];
#pragma unroll
    for (int i = 0; i < 2; ++i) { int R, C; stage_rc(tid * 16 + i * 8192, R, C); const int Rb = (R & ~31) + perm32(R & 31); RA[i] = R; CA[i] = C; voffB[i] = (unsigned)(Rb * K + C) * 2u; }
    const size_t kstep = (size_t)(BK * 2);
    const size_t hstep = (size_t)HALF * K * 2;
    const unsigned ldsw = (unsigned)wid * 1024u;
    const int aoff = lds_byte(wr * 64 + fr, fq * 8), boff = lds_byte(wc * 32 + fr, fq * 8);
#define PG8_SA(b, h) (((b) * 2 + (h)) * HTB)
#define PG8_SB(b, h) ((4 + (b) * 2 + (h)) * HTB)
#define PG8_STAGE2(bufoff, gbase, o0, o1) do { \
        __builtin_amdgcn_global_load_lds((const unsigned*)((const char*)(gbase) + (o0)), (LAS unsigned*)(lds + (bufoff) + ldsw), 16, 0, 0); \
        __builtin_amdgcn_global_load_lds((const unsigned*)((const char*)(gbase) + (o1)), (LAS unsigned*)(lds + (bufoff) + ldsw + 8192), 16, 0, 0); } while (0)
#define PG8_STB(bufoff, gbase) PG8_STAGE2(bufoff, gbase, voffB[0], voffB[1])
#define PG8_STA(bufoff, gbase, OFF, h) PG8_STAGE2(bufoff, gbase, OFF[h][0], OFF[h][1])
#define PG8_LDA(dst, b, h) do { _Pragma("unroll") for (int m = 0; m < 4; ++m) _Pragma("unroll") for (int k = 0; k < 2; ++k) dst[m][k] = *(const LAS bf16x8*)(lds + PG8_SA(b, h) + aoff + m * 2048 + k * 1024); } while (0)
#define PG8_LDB(dst, b, h) do { _Pragma("unroll") for (int n = 0; n < 2; ++n) _Pragma("unroll") for (int k = 0; k < 2; ++k) dst[n][k] = *(const LAS bf16x8*)(lds + PG8_SB(b, h) + boff + n * 2048 + k * 1024); } while (0)
#define PG8_MMA(ai, bj, At, Bt) do { __builtin_amdgcn_s_setprio(1); _Pragma("unroll") for (int m = 0; m < 4; ++m) _Pragma("unroll") for (int n = 0; n < 2; ++n) _Pragma("unroll") for (int k = 0; k < 2; ++k) \
        acc[ai][bj][m][n] = __builtin_amdgcn_mfma_f32_16x16x32_bf16(Bt[n][k], At[m][k], acc[ai][bj][m][n], 0, 0, 0); __builtin_amdgcn_s_setprio(0); } while (0)
#define PG8_WAIT_V(n) asm volatile("s_waitcnt vmcnt(" #n ")" ::: "memory")
#define PG8_WAIT_L(n) asm volatile("s_waitcnt lgkmcnt(" #n ")" ::: "memory")
#define PG8_BAR __builtin_amdgcn_s_barrier()
#define PG8_SCHED __builtin_amdgcn_sched_barrier(0)
#define PG8_AOFF(OFF, u) do { _Pragma("unroll") for (int h_ = 0; h_ < 2; ++h_) _Pragma("unroll") for (int i_ = 0; i_ < 2; ++i_) { \
        if constexpr (GATHER) { const int r_ = h_ * HALF + RA[i_]; const int t_ = (r_ < (u).valid) ? g.tok[(u).e * NTOK + (u).pos0 + r_] : 0; OFF[h_][i_] = (unsigned)(t_ * K + CA[i_]) * 2u; } \
        else OFF[h_][i_] = (unsigned)((h_ * HALF + RA[i_]) * K + CA[i_]) * 2u; } } while (0)
    Unit cur, nxt; int ui = 0;
    if (!S.next(0, cur)) return;
    f32x4 acc[2][2][4][2];
#pragma unroll
    for (int a = 0; a < 2; ++a)
#pragma unroll
        for (int b = 0; b < 2; ++b)
#pragma unroll
            for (int m = 0; m < 4; ++m)
#pragma unroll
                for (int n = 0; n < 2; ++n) acc[a][b][m][n] = (f32x4){0.f, 0.f, 0.f, 0.f};
    bf16x8 At[4][2], B0[2][2], B1[2][2];
    unsigned coff[2][2], noff[2][2];
    PG8_AOFF(coff, cur);
    const char* cA = (const char*)g.A + (GATHER ? (size_t)0 : (size_t)cur.row0 * K * 2);
    const char* cB = (const char*)g.Bt + ((size_t)cur.e * g.bstride + (size_t)cur.col0 * K) * 2;
    PG8_STB(PG8_SB(0, 0), cB); PG8_STB(PG8_SB(0, 1), cB + hstep); PG8_STA(PG8_SA(0, 0), cA, coff, 0); PG8_STA(PG8_SA(0, 1), cA, coff, 1);
    if (wr == 1) PG8_BAR;
    PG8_WAIT_V(2); PG8_BAR;
    PG8_STB(PG8_SB(1, 0), cB + kstep); PG8_STA(PG8_SA(1, 0), cA + kstep, coff, 0); PG8_STB(PG8_SB(1, 1), cB + hstep + kstep);
    PG8_WAIT_V(6); PG8_BAR;
    for (;;) {
        const bool has_next = S.next(ui + 1, nxt);
        const char* nA = cA; const char* nB = cB;
        if (has_next) { nA = (const char*)g.A + (GATHER ? (size_t)0 : (size_t)nxt.row0 * K * 2); nB = (const char*)g.Bt + ((size_t)nxt.e * g.bstride + (size_t)nxt.col0 * K) * 2; PG8_AOFF(noff, nxt); }
        else {
#pragma unroll
            for (int h_ = 0; h_ < 2; ++h_)
#pragma unroll
                for (int i_ = 0; i_ < 2; ++i_) noff[h_][i_] = coff[h_][i_];
        }
        for (int t = 0; t < nt; t += 2) {
            const bool last = (t == nt - 2);
            const char* a1 = cA + (size_t)(t + 1) * kstep;
            const char* a2 = last ? nA : cA + (size_t)(t + 2) * kstep; const char* b2 = last ? nB : cB + (size_t)(t + 2) * kstep;
            const char* a3 = a2 + kstep; const char* b3 = b2 + kstep;
            unsigned o2[2][2];
#pragma unroll
            for (int h_ = 0; h_ < 2; ++h_)
#pragma unroll
                for (int i_ = 0; i_ < 2; ++i_) o2[h_][i_] = (GATHER && last) ? noff[h_][i_] : coff[h_][i_];
            PG8_LDB(B0, 0, 0); PG8_LDB(B1, 0, 1); PG8_SCHED; PG8_LDA(At, 0, 0); PG8_STA(PG8_SA(1, 1), a1, coff, 1);
            PG8_WAIT_V(8); PG8_WAIT_L(0); PG8_BAR; PG8_MMA(0, 0, At, B0); PG8_MMA(0, 1, At, B1); PG8_BAR; PG8_SCHED;
            PG8_LDA(At, 0, 1); PG8_STB(PG8_SB(0, 0), b2); PG8_STB(PG8_SB(0, 1), b2 + hstep); PG8_STA(PG8_SA(0, 0), a2, o2, 0);
            PG8_WAIT_V(8); PG8_WAIT_L(0); PG8_BAR; PG8_MMA(1, 0, At, B0); PG8_MMA(1, 1, At, B1); PG8_BAR; PG8_SCHED;
            PG8_LDB(B0, 1, 0); PG8_LDB(B1, 1, 1); PG8_SCHED; PG8_LDA(At, 1, 0); PG8_STA(PG8_SA(0, 1), a2, o2, 1);
            PG8_WAIT_V(8); PG8_WAIT_L(0); PG8_BAR; PG8_MMA(0, 0, At, B0); PG8_MMA(0, 1, At, B1); PG8_BAR; PG8_SCHED;
            PG8_LDA(At, 1, 1); PG8_STB(PG8_SB(1, 0), b3); PG8_STB(PG8_SB(1, 1), b3 + hstep); PG8_STA(PG8_SA(1, 0), a3, o2, 0);
            PG8_WAIT_V(8); PG8_WAIT_L(0); PG8_BAR; PG8_MMA(1, 0, At, B0); PG8_MMA(1, 1, At, B1); PG8_BAR; PG8_SCHED;
        }
        if constexpr (ALIGN_EPI) { if (wr == 0) PG8_BAR; }
        E(acc, cur, wr, wc, fr, fq);
        if (!has_next) break;
#pragma unroll
        for (int a = 0; a < 2; ++a)
#pragma unroll
            for (int b = 0; b < 2; ++b)
#pragma unroll
                for (int m = 0; m < 4; ++m)
#pragma unroll
                    for (int n = 0; n < 2; ++n) acc[a][b][m][n] = (f32x4){0.f, 0.f, 0.f, 0.f};
        cur = nxt; cA = nA; cB = nB; ++ui;
#pragma unroll
        for (int h_ = 0; h_ < 2; ++h_)
#pragma unroll
            for (int i_ = 0; i_ < 2; ++i_) coff[h_][i_] = noff[h_][i_];
        if constexpr (ALIGN_EPI) { if (wr == 1) PG8_BAR; }
    }
    PG8_WAIT_V(0);
    if constexpr (!ALIGN_EPI) { if (wr == 0) PG8_BAR; }
    PG8_BAR;
#undef PG8_SA
#undef PG8_SB
#undef PG8_STAGE2
#undef PG8_STB
#undef PG8_STA
#undef PG8_LDA
#undef PG8_LDB
#undef PG8_MMA
#undef PG8_WAIT_V
#undef PG8_WAIT_L
#undef PG8_BAR
#undef PG8_SCHED
#undef PG8_AOFF
}

template <class Epi, class Sched>
__device__ __forceinline__ void naive_gemm_phase(LAS unsigned char* lds, const int wid, const Gemm g, const Sched& S, const Epi& E) {
    LAS float* As = (LAS float*)lds; LAS float* Bs = As + 64 * 36;
    const int tid = (wid << 6) | fresh_lane(), r = tid >> 3, c8 = (tid & 7) * 8, K = g.K, lr4 = tid >> 3, kq = (tid & 7) * 4;
    Unit u;
    for (int i = 0; S.next(i, u); ++i) {
        const bf16* Bt = g.Bt + (size_t)u.e * g.bstride + (size_t)u.col0 * K;
        for (int sub = 0; sub < 16; ++sub) {
            const int sr = (sub >> 2) * 64, sc = (sub & 3) * 64;
            float acc[8], pacc[8];
#pragma unroll
            for (int j = 0; j < 8; ++j) { acc[j] = 0.f; pacc[j] = 0.f; }
            const bool need_p = E.needs_partner(u, sc + c8);
            const int ur = sr + lr4;
            long arow;
            if (g.tok) arow = (ur < u.valid) ? (long)g.tok[u.e * NTOK + u.pos0 + ur] : 0; else arow = (long)u.row0 + ur;
            const bf16* ap = g.A + (size_t)arow * K + kq; const bf16* bp = Bt + (size_t)(sc + lr4) * K + kq;
            for (int k0 = 0; k0 < K; k0 += 32) {
                __syncthreads();
                { const v2u a = *(const v2u*)(ap + k0), b = *(const v2u*)(bp + k0);
                  LAS float* ad = As + lr4 * 36 + kq; LAS float* bd = Bs + lr4 * 36 + kq;
                  ad[0] = bflo(a.x); ad[1] = bfhi(a.x); ad[2] = bflo(a.y); ad[3] = bfhi(a.y);
                  bd[0] = bflo(b.x); bd[1] = bfhi(b.x); bd[2] = bflo(b.y); bd[3] = bfhi(b.y); }
                __syncthreads();
#pragma unroll 1
                for (int kk = 0; kk < 32; kk += 4) {
                    const f32x4 a4 = *(const LAS f32x4*)(As + r * 36 + kk);
#pragma unroll
                    for (int j = 0; j < 8; ++j) { const f32x4 b4 = *(const LAS f32x4*)(Bs + (c8 + j) * 36 + kk); acc[j] += (a4.x * b4.x + a4.y * b4.y) + (a4.z * b4.z + a4.w * b4.w); }
                    if (need_p) {
#pragma unroll
                        for (int j = 0; j < 8; ++j) { const f32x4 b4 = *(const LAS f32x4*)(Bs + ((c8 ^ 8) + j) * 36 + kk); pacc[j] += (a4.x * b4.x + a4.y * b4.y) + (a4.z * b4.z + a4.w * b4.w); }
                    }
                }
            }
            E.naive(u, sr + r, sc + c8, acc, pacc);
        }
    }
    __syncthreads();
}
}
namespace epi {
using pg8::Unit; using pg8::HALF;
#define EPI_ROWS_BEGIN _Pragma("unroll") for (int ai = 0; ai < 2; ++ai) _Pragma("unroll") for (int m = 0; m < 4; ++m) { const int lr = ai * HALF + wr * 64 + m * 16 + fr;
#define EPI_ROWS_END }
#define EPI_V8(v, ai, bj, m) float v[8]; { const f32x4 a_ = acc[ai][bj][m][0], b_ = acc[ai][bj][m][1]; v[0] = a_[0]; v[1] = a_[1]; v[2] = a_[2]; v[3] = a_[3]; v[4] = b_[0]; v[5] = b_[1]; v[6] = b_[2]; v[7] = b_[3]; }
typedef f32x4 AccT[2][2][4][2];

struct EpiZ {
    bf16* Z; const float* ss; const float* tab;
    __device__ __forceinline__ void group(int row, int col, float (&v)[8], const float (&pv)[8]) const {
        if (col < 1024) {
            const int d = col & 63;
            if (d < 16) {
                const f32x4* t = (const f32x4*)(tab + (size_t)row * 16);
                const f32x4 c0 = t[0], c1 = t[1], s0 = t[2], s1 = t[3];
                const float cs[8] = {c0[0], c0[1], c0[2], c0[3], c1[0], c1[1], c1[2], c1[3]}, sn[8] = {s0[0], s0[1], s0[2], s0[3], s1[0], s1[1], s1[2], s1[3]};
                if (d < 8) {
#pragma unroll
                    for (int j = 0; j < 8; ++j) v[j] = v[j] * cs[j] - pv[j] * sn[j];
                } else {
#pragma unroll
                    for (int j = 0; j < 8; ++j) v[j] = v[j] * cs[j] + pv[j] * sn[j];
                }
            }
            if (col < 512) {
#pragma unroll
                for (int j = 0; j < 8; ++j) v[j] *= ATT_C2;
            }
        }
        *(v4u*)(Z + (size_t)row * ZW + col) = pk8(v);
    }
    __device__ __forceinline__ void operator()(const AccT& acc, const Unit& u, int wr, int wc, int fr, int fq) const {
        const bool qk = u.col0 < 1024;
        EPI_ROWS_BEGIN
            const int row = u.row0 + lr; const float s = rscale16(ss, row);
#pragma unroll
            for (int bj = 0; bj < 2; ++bj) { EPI_V8(v, ai, bj, m)
                float pv[8];
#pragma unroll
                for (int j = 0; j < 8; ++j) { v[j] *= s; pv[j] = qk ? __shfl_xor(v[j], 16) : 0.f; }
                group(row, u.col0 + bj * HALF + wc * 32 + 8 * fq, v, pv); } EPI_ROWS_END
    }
    __device__ __forceinline__ bool needs_partner(const Unit& u, int lc) const { return u.col0 < 1024 && (lc & 63) < 16; }
    __device__ __forceinline__ void naive(const Unit& u, int lr, int lc, float (&v)[8], float (&pv)[8]) const {
        const int row = u.row0 + lr; const float s = rscale16(ss, row);
#pragma unroll
        for (int j = 0; j < 8; ++j) { v[j] *= s; pv[j] *= s; }
        group(row, u.col0 + lc, v, pv);
    }
};

template <int MODE> struct EpiRes {
    const float* res; float* out; bf16* hb; float* ss_out; const float* ss_in; const bf16* pp;
    __device__ __forceinline__ float group(int row, int col, float s, const float (&v)[8]) const {
        const size_t off = (size_t)row * DM + col;
        const f32x4 r0 = *(const f32x4*)(res + off), r1 = *(const f32x4*)(res + off + 4);
        float o[8] = {r0[0], r0[1], r0[2], r0[3], r1[0], r1[1], r1[2], r1[3]};
        if (MODE == 2) {
            float pv[8]; unpk8(*(const v4u*)(pp + off), pv);
#pragma unroll
            for (int j = 0; j < 8; ++j) o[j] += sigmoidf_(s * v[j]) * pv[j];
        } else {
#pragma unroll
            for (int j = 0; j < 8; ++j) o[j] += v[j];
        }
        *(f32x4*)(out + off) = (f32x4){o[0], o[1], o[2], o[3]}; *(f32x4*)(out + off + 4) = (f32x4){o[4], o[5], o[6], o[7]};
        *(v4u*)(hb + off) = pk8(o);
        float q = 0.f;
#pragma unroll
        for (int j = 0; j < 8; ++j) q += o[j] * o[j];
        return q;
    }
    __device__ __forceinline__ void operator()(const AccT& acc, const Unit& u, int wr, int wc, int fr, int fq) const {
        EPI_ROWS_BEGIN
            const int row = u.row0 + lr; const float s = (MODE == 2) ? rscale16(ss_in, row) : 1.f; float q = 0.f;
#pragma unroll
            for (int bj = 0; bj < 2; ++bj) { EPI_V8(v, ai, bj, m) q += group(row, u.col0 + bj * HALF + wc * 32 + 8 * fq, s, v); }
            q += __shfl_xor(q, 16); q += __shfl_xor(q, 32);
            if (fq == 0) ss_out[(size_t)row * 16 + (u.col0 >> 8) * 4 + wc] = q; EPI_ROWS_END
    }
    __device__ __forceinline__ bool needs_partner(const Unit&, int) const { return false; }
    __device__ __forceinline__ void naive(const Unit& u, int lr, int lc, float (&v)[8], float (&)[8]) const {
        const int row = u.row0 + lr; const float s = (MODE == 2) ? rscale16(ss_in, row) : 1.f;
        (void)group(row, u.col0 + lc, s, v);
    }
};

template <bool MOE> struct EpiGlu {
    bf16* act; const float* ss;
    __device__ __forceinline__ void group(size_t orow, int col, float s, const float (&v)[8]) const {
        float o[4];
#pragma unroll
        for (int j = 0; j < 4; ++j) o[j] = siluf_(s * v[j]) * (s * v[4 + j]);
        v2u w; w.x = pk2(o[0], o[1]); w.y = pk2(o[2], o[3]);
        *(v2u*)(act + orow * DFF + (col >> 1)) = w;
    }
    __device__ __forceinline__ void operator()(const AccT& acc, const Unit& u, int wr, int wc, int fr, int fq) const {
        EPI_ROWS_BEGIN
            if (!MOE || lr < u.valid) {
                const int row = u.row0 + lr; const float s = MOE ? ss[u.e * NTOK + u.pos0 + lr] : rscale16(ss, row);
#pragma unroll
                for (int bj = 0; bj < 2; ++bj) { EPI_V8(v, ai, bj, m) group((size_t)row, u.col0 + bj * HALF + wc * 32 + 8 * fq, s, v); }
            } EPI_ROWS_END
    }
    __device__ __forceinline__ bool needs_partner(const Unit&, int) const { return false; }
    __device__ __forceinline__ void naive(const Unit& u, int lr, int lc, float (&v)[8], float (&)[8]) const {
        if (MOE && lr >= u.valid) return;
        const int row = u.row0 + lr; const float s = MOE ? ss[u.e * NTOK + u.pos0 + lr] : rscale16(ss, row);
        group((size_t)row, u.col0 + lc, s, v);
    }
};

struct EpiGelu {
    bf16* UV; const float* ss; float* lns; float* lnq;
    __device__ __forceinline__ void group(int row, int col, float s, float (&v)[8], float& sum, float& sq) const {
#pragma unroll
        for (int j = 0; j < 8; ++j) { v[j] = geluf_(s * v[j]); sum += v[j]; sq += v[j] * v[j]; }
        *(v4u*)(UV + (size_t)row * 2048 + col) = pk8(v);
    }
    __device__ __forceinline__ void operator()(const AccT& acc, const Unit& u, int wr, int wc, int fr, int fq) const {
        const bool vh = u.col0 >= 1024;
        EPI_ROWS_BEGIN
            const int row = u.row0 + lr; const float s = rscale16(ss, row); float sum = 0.f, sq = 0.f;
#pragma unroll
            for (int bj = 0; bj < 2; ++bj) { EPI_V8(v, ai, bj, m) group(row, u.col0 + bj * HALF + wc * 32 + 8 * fq, s, v, sum, sq); }
            if (vh) { sum += __shfl_xor(sum, 16); sum += __shfl_xor(sum, 32); sq += __shfl_xor(sq, 16); sq += __shfl_xor(sq, 32);
                if (fq == 0) { const size_t o = (size_t)row * 16 + ((u.col0 - 1024) >> 8) * 4 + wc; lns[o] = sum; lnq[o] = sq; } } EPI_ROWS_END
    }
    __device__ __forceinline__ bool needs_partner(const Unit&, int) const { return false; }
    __device__ __forceinline__ void naive(const Unit& u, int lr, int lc, float (&v)[8], float (&)[8]) const {
        const int row = u.row0 + lr; const float s = rscale16(ss, row); float sum = 0.f, sq = 0.f;
        group(row, u.col0 + lc, s, v, sum, sq);
    }
};

template <bool MOE> struct EpiStore {
    bf16* O; const float* gate;
    __device__ __forceinline__ void group(size_t orow, int col, float s, float (&v)[8]) const {
#pragma unroll
        for (int j = 0; j < 8; ++j) v[j] *= s;
        *(v4u*)(O + orow * DM + col) = pk8(v);
    }
    __device__ __forceinline__ void operator()(const AccT& acc, const Unit& u, int wr, int wc, int fr, int fq) const {
        EPI_ROWS_BEGIN
            if (!MOE || lr < u.valid) {
                const float s = MOE ? gate[u.e * NTOK + u.pos0 + lr] : 1.f;
#pragma unroll
                for (int bj = 0; bj < 2; ++bj) { EPI_V8(v, ai, bj, m) group((size_t)(u.row0 + lr), u.col0 + bj * HALF + wc * 32 + 8 * fq, s, v); }
            } EPI_ROWS_END
    }
    __device__ __forceinline__ bool needs_partner(const Unit&, int) const { return false; }
    __device__ __forceinline__ void naive(const Unit& u, int lr, int lc, float (&v)[8], float (&)[8]) const {
        if (MOE && lr >= u.valid) return;
        const float s = MOE ? gate[u.e * NTOK + u.pos0 + lr] : 1.f;
        group((size_t)(u.row0 + lr), u.col0 + lc, s, v);
    }
};
#undef EPI_ROWS_BEGIN
#undef EPI_ROWS_END
#undef EPI_V8
}
namespace attn_body {
using bf16=__hip_bfloat16;
using bf16x8=__attribute__((ext_vector_type(8)))short;
using s16x4=__attribute__((ext_vector_type(4)))short;
using f32x16=__attribute__((ext_vector_type(16)))float;
using u32x4=__attribute__((ext_vector_type(4)))unsigned;
constexpr int SEQ=4096,D=64,PIN=3072,POUT=1024;
constexpr int NW=8,QBLK=32,QB=QBLK*NW,KVBLK=64,NQB=SEQ/QB;
constexpr int ATTN_UNIT_ROWS=QB;
__device__ __forceinline__ int crow(int r,int hi){return (r&3)+8*(r>>2)+4*hi;}
#define SBAR() __builtin_amdgcn_sched_barrier(0)
__device__ __forceinline__ void cmask(f32x16&p0,f32x16&p1,int jb,int qrel,int hi){
  const float NEG=-INFINITY; int kb=64*jb+4*hi;
  #pragma unroll
  for(int r=0;r<16;++r){int kv=kb+(r&3)+8*(r>>2); if(kv>qrel)p0[r]=NEG; if(kv+32>qrel)p1[r]=NEG;}
}

constexpr int NSLOT=3, SLOTB=8192;
constexpr int LDS_K=0, LDS_V=NSLOT*SLOTB, LDS_WS=2*NSLOT*SLOTB, LDS_OST=LDS_WS+NW*64*4, LDS_BYTES=LDS_OST+NW*4096;
constexpr float C2=0.125f*1.4426950408889634f;
__device__ __forceinline__ void glds16(const void*gsrc,unsigned lds_dst){unsigned keep;
  asm volatile("s_mov_b32 %0, m0\n\ts_mov_b32 m0, %2\n\ts_nop 0\n\tglobal_load_lds_dwordx4 %1, off\n\ts_mov_b32 m0, %0":"=&s"(keep):"v"(gsrc),"s"(lds_dst):"memory");}
__device__ __forceinline__ float max3f(float a,float b,float c){float r;asm("v_max3_f32 %0, %1, %2, %3":"=v"(r):"v"(a),"v"(b),"v"(c));return r;}
__device__ __forceinline__ float max2f(float a,float b){float r;asm("v_max_f32_e32 %0, %1, %2":"=v"(r):"v"(a),"v"(b));return r;}
__device__ __forceinline__ float fadd_s(float a,float b){float r;asm("v_add_f32_e32 %0, %1, %2":"=v"(r):"v"(a),"v"(b));return r;}
__device__ __forceinline__ float fsub_s(float a,float b){float r;asm("v_sub_f32_e32 %0, %1, %2":"=v"(r):"v"(a),"v"(b));return r;}
typedef float f32x2_t __attribute__((ext_vector_type(2))); typedef __bf16 bf16x2_t __attribute__((ext_vector_type(2)));
__device__ __forceinline__ unsigned cvtpk_s(float lo,float hi){f32x2_t v={lo,hi};bf16x2_t b=__builtin_convertvector(v,bf16x2_t);return __builtin_bit_cast(unsigned,b);}
#define WAIT_BAR(N) asm volatile("s_waitcnt vmcnt(" #N ") lgkmcnt(0)\n\ts_barrier":::"memory")

__device__ __forceinline__ void qkt(f32x16&p0,f32x16&p1,const char*Kslot,const bf16x8*qr,const f32x16&negm,int r32,int hi){
  const char*kb=Kslot+hi*1024+r32*16;
  #pragma unroll
  for(int d0=0;d0<4;++d0){
    const bf16x8 b0=*reinterpret_cast<const bf16x8*>(kb+d0*2048);
    const bf16x8 b1=*reinterpret_cast<const bf16x8*>(kb+d0*2048+512);
    if(d0==0){p0=__builtin_amdgcn_mfma_f32_32x32x16_bf16(b0,qr[0],negm,0,0,0);p1=__builtin_amdgcn_mfma_f32_32x32x16_bf16(b1,qr[0],negm,0,0,0);}
    else{p0=__builtin_amdgcn_mfma_f32_32x32x16_bf16(b0,qr[d0],p0,0,0,0);p1=__builtin_amdgcn_mfma_f32_32x32x16_bf16(b1,qr[d0],p1,0,0,0);}}
}
typedef __attribute__((address_space(3))) const char* lds_cptr;
typedef short v4i16_t __attribute__((ext_vector_type(4)));
__device__ __forceinline__ void kload8(bf16x8*kf,lds_cptr kp){
  kf[0]=*(const __attribute__((address_space(3))) bf16x8*)(kp);      kf[1]=*(const __attribute__((address_space(3))) bf16x8*)(kp+512);
  kf[2]=*(const __attribute__((address_space(3))) bf16x8*)(kp+2048); kf[3]=*(const __attribute__((address_space(3))) bf16x8*)(kp+2560);
  kf[4]=*(const __attribute__((address_space(3))) bf16x8*)(kp+4096); kf[5]=*(const __attribute__((address_space(3))) bf16x8*)(kp+4608);
  kf[6]=*(const __attribute__((address_space(3))) bf16x8*)(kp+6144); kf[7]=*(const __attribute__((address_space(3))) bf16x8*)(kp+6656);
}
__device__ __forceinline__ void kload2(bf16x8*kf,lds_cptr kp,int j){ kf[2*j]=*(const __attribute__((address_space(3))) bf16x8*)(kp+j*2048); kf[2*j+1]=*(const __attribute__((address_space(3))) bf16x8*)(kp+j*2048+512); }
__device__ __forceinline__ s16x4 vtr(lds_cptr p){ return __builtin_bit_cast(s16x4,__builtin_amdgcn_ds_read_tr16_b64_v4i16((__attribute__((address_space(3))) v4i16_t*)p)); }
__device__ __forceinline__ float rowmax(const f32x16&p0,const f32x16&p1){
  float a=max3f(p0[0],p0[1],p1[0]),b=max3f(p0[2],p0[3],p1[1]);a=max3f(a,p1[2],p1[3]);
  #pragma unroll
  for(int r=4;r<16;r+=4){a=max3f(a,p0[r],p0[r+1]);b=max3f(b,p0[r+2],p0[r+3]);a=max3f(a,p1[r],p1[r+1]);b=max3f(b,p1[r+2],p1[r+3]);}
  const float m=max2f(a,b);
  auto rr=__builtin_amdgcn_permlane32_swap(__float_as_uint(m),__float_as_uint(m),false,false);
  return max2f(__uint_as_float(rr[0]),__uint_as_float(rr[1]));
}
__device__ __forceinline__ void pv(f32x16*o,int vb,bf16x8 pa0,bf16x8 pa1,bf16x8 pa2,bf16x8 pa3){
  #pragma unroll
  for(int d0=0;d0<2;++d0){s16x4 lo[4],hi[4];
    #pragma unroll
    for(int ks=0;ks<4;++ks){
      asm volatile("ds_read_b64_tr_b16 %0,%1 offset:%c2":"=&v"(lo[ks]):"v"(vb),"i"(d0*4096+ks*1024):"memory");
      asm volatile("ds_read_b64_tr_b16 %0,%1 offset:%c2":"=&v"(hi[ks]):"v"(vb),"i"(d0*4096+ks*1024+512):"memory");}
    asm volatile("s_waitcnt lgkmcnt(0)":::"memory");SBAR();
    #define PK(k) (bf16x8){lo[k][0],lo[k][1],lo[k][2],lo[k][3],hi[k][0],hi[k][1],hi[k][2],hi[k][3]}
    o[d0]=__builtin_amdgcn_mfma_f32_32x32x16_bf16(pa0,PK(0),o[d0],0,0,0);
    o[d0]=__builtin_amdgcn_mfma_f32_32x32x16_bf16(pa1,PK(1),o[d0],0,0,0);
    o[d0]=__builtin_amdgcn_mfma_f32_32x32x16_bf16(pa2,PK(2),o[d0],0,0,0);
    o[d0]=__builtin_amdgcn_mfma_f32_32x32x16_bf16(pa3,PK(3),o[d0],0,0,0);
    #undef PK
  }
}

#ifndef ATTN_STORE16
#define ATTN_STORE16(p,v) (*(u32x4*)(p)=(v))
#endif
template<int THRL> __device__ __forceinline__ void attn_unit(const int wid,int b,int qb,const bf16*Q,const bf16*__restrict__ K,const bf16*__restrict__ V,bf16*O,char*shm){
  const int lane=fresh_lane(),r32=lane&31,hi=lane>>5;
  const long rowbase=(long)b*SEQ; const int q0=qb*QB;
  const bf16*Qw=Q+(rowbase+q0+wid*QBLK)*PIN;
  const bf16*Kh=K+rowbase*PIN,*Vh=V+rowbase*PIN;
  const unsigned lds0=(unsigned)(uintptr_t)shm;
  float*wsf=(float*)(shm+LDS_WS)+wid*64;
  const bf16*ksrc=Kh+(long)lane*PIN+wid*8;
  const bf16*vsrc=Vh+(long)(16*(wid&3)+(lane>>2))*PIN+(wid>>2)*32+(lane&3)*8;
  const unsigned kdst=lds0+LDS_K+wid*1024, vdst=lds0+LDS_V+wid*1024;
  #define DMA_K(t,slot) glds16(ksrc+(long)(t)*KVBLK*PIN,(unsigned)__builtin_amdgcn_readfirstlane(kdst+(slot)))
  #define DMA_V(t,slot) glds16(vsrc+(long)(t)*KVBLK*PIN,(unsigned)__builtin_amdgcn_readfirstlane(vdst+(slot)))
  const int vb0=(int)(lds0+LDS_V)+((lane>>4)&1)*32+(lane&3)*8+(4*hi+((lane&15)>>2))*64;
  const char*Kbase=shm+LDS_K; bf16x8 kf[8];
  const lds_cptr shm3=(lds_cptr)shm; const lds_cptr kp0=shm3+LDS_K+hi*1024+r32*16; const lds_cptr vp0=shm3+LDS_V+((lane>>4)&1)*32+(lane&3)*8+(4*hi+((lane&15)>>2))*64;
  const int NT=(q0+QB)/KVBLK;
  DMA_K(0,0);DMA_V(0,0);DMA_K(1,SLOTB);
  bf16x8 qr[4];
  #pragma unroll
  for(int d0=0;d0<4;++d0)qr[d0]=*reinterpret_cast<const bf16x8*>(&Qw[(long)r32*PIN+d0*16+hi*8]);
  float mhat=0.f,l_reg=0.f;f32x16 o[2];o[0]=f32x16{};o[1]=f32x16{};f32x16 negm=f32x16{};asm volatile("":"+v"(negm));
  const int qrel=wid*QBLK+r32;
  #define CMASK(P0,P1,t) do{int jb_=(t)-(NT-4); if(jb_>=0)cmask(P0,P1,jb_,qrel,hi);}while(0)
  bool resc=false;
  #define START(P0,P1) do{ const float rm=rowmax(P0,P1); resc=false; \
    { const float dl=rm; mhat=fadd_s(mhat,dl); \
      _Pragma("unroll") for(int r=0;r<16;++r){P0[r]=fsub_s(P0[r],dl);P1[r]=fsub_s(P1[r],dl);} \
      _Pragma("unroll") for(int r=0;r<16;++r)negm[r]=-mhat; asm volatile("":"+v"(negm)); } \
    _Pragma("unroll") for(int r=0;r<16;++r)P0[r]=__builtin_amdgcn_exp2f(P0[r]); }while(0)
  #define RESC() do{ if(resc){ asm volatile("s_waitcnt lgkmcnt(0)":::"memory"); \
      _Pragma("unroll") for(int d_=0;d_<2;++d_) _Pragma("unroll") for(int r=0;r<16;++r)o[d_][r]*=wsf[crow(r,hi)]; } }while(0)
  f32x16 pA0,pA1,pB0,pB1;
  int sl_prev=0,sl_cur=0,sl_next=SLOTB;
  #define ROT() do{sl_prev=sl_cur;sl_cur=sl_next;sl_next=(sl_next==(NSLOT-1)*SLOTB)?0:sl_next+SLOTB;}while(0)
  DMA_K(2,2*SLOTB);
  WAIT_BAR(3);
  qkt(pA0,pA1,Kbase,qr,negm,r32,hi);asm volatile("s_nop 15\n\ts_nop 7":"+v"(pA0),"+v"(pA1));CMASK(pA0,pA1,0);
  START(pA0,pA1);
  _Pragma("unroll") for(int r=0;r<16;++r)pA1[r]=__builtin_amdgcn_exp2f(pA1[r]);
  WAIT_BAR(0);
  DMA_K(3,0);DMA_V(1,SLOTB);
  ROT();
  kload8(kf,kp0+sl_cur);
  WAIT_BAR(2);
  s16x4 vlo[8],vhi[8]; u32x4 pw0,pw1,pw2,pw3;
  #define PKW(P,B) cvtpk_s(P[B],P[B+1])
  #define PAF(k) __builtin_bit_cast(bf16x8,pw##k)
  #define VFR(i) (bf16x8){vlo[i][0],vlo[i][1],vlo[i][2],vlo[i][3],vhi[i][0],vhi[i][1],vhi[i][2],vhi[i][3]}
  #define PIN(x) asm volatile("":"+v"(x))
  #define MX3(a,b,c) __builtin_fmaxf(__builtin_fmaxf((a),(b)),(c))
  #define GAPA(MF,A0,A1,A2,A3,W0,W1,PW) do{ MF; sacc+=A0; sacc+=A1; sacc+=A2; sacc+=A3; PIN(sacc); W0; W1; PIN(PW); SBAR(); }while(0)
  #define EX(v) __builtin_amdgcn_exp2f(v)
  #define GAPB(MF,X,B) do{ MF; X[B]=EX(X[B]); X[B+1]=EX(X[B+1]); X[B+2]=EX(X[B+2]); X[B+3]=EX(X[B+3]); PIN(X); SBAR(); }while(0)
  #define VRD(i) do{ vlo[i]=vtr(vp_+(((i)>>2)*4096+((i)&3)*1024)); vhi[i]=vtr(vp_+(((i)>>2)*4096+((i)&3)*1024+512)); }while(0)
  #define KRD(G,j) do{ if(G){ kload2(kf,kp0+sl_next,j); SBAR(); } }while(0)
  #define STEP(C0,C1,P0,P1,t,GK,GV,GL) do{ SBAR(); \
    const lds_cptr vp_=vp0+sl_prev; \
    VRD(0); SBAR(); float sacc=(P0[0]+P0[1]); \
    GAPA(C0=__builtin_amdgcn_mfma_f32_32x32x16_bf16(kf[0],qr[0],negm,0,0,0), P0[2],P0[3],P0[4],P0[5],     pw0[0]=PKW(P0,0), pw0[1]=PKW(P0,2), pw0); \
    VRD(4); SBAR(); GAPA(C1=__builtin_amdgcn_mfma_f32_32x32x16_bf16(kf[1],qr[0],negm,0,0,0), P0[6],P0[7],P0[8],P0[9],     pw0[2]=PKW(P0,4), pw0[3]=PKW(P0,6), pw0); \
    VRD(1); SBAR(); GAPA(C0=__builtin_amdgcn_mfma_f32_32x32x16_bf16(kf[2],qr[1],C0,0,0,0),   P0[10],P0[11],P0[12],P0[13], pw1[0]=PKW(P0,8), pw1[1]=PKW(P0,10), pw1); \
    VRD(5); SBAR(); GAPA(C1=__builtin_amdgcn_mfma_f32_32x32x16_bf16(kf[3],qr[1],C1,0,0,0),   P0[14],P0[15],P1[0],P1[1],   pw1[2]=PKW(P0,12),pw1[3]=PKW(P0,14), pw1); \
    VRD(2); SBAR(); GAPA(C0=__builtin_amdgcn_mfma_f32_32x32x16_bf16(kf[4],qr[2],C0,0,0,0),   P1[2],P1[3],P1[4],P1[5],     pw2[0]=PKW(P1,0), pw2[1]=PKW(P1,2), pw2); \
    VRD(6); SBAR(); GAPA(C1=__builtin_amdgcn_mfma_f32_32x32x16_bf16(kf[5],qr[2],C1,0,0,0),   P1[6],P1[7],P1[8],P1[9],     pw2[2]=PKW(P1,4), pw2[3]=PKW(P1,6), pw2); \
    VRD(3); SBAR(); GAPA(C0=__builtin_amdgcn_mfma_f32_32x32x16_bf16(kf[6],qr[3],C0,0,0,0),   P1[10],P1[11],P1[12],P1[13], pw3[0]=PKW(P1,8), pw3[1]=PKW(P1,10), pw3); \
    VRD(7); SBAR(); GAPA(C1=__builtin_amdgcn_mfma_f32_32x32x16_bf16(kf[7],qr[3],C1,0,0,0),   P1[14],P1[15],0.f,0.f,       pw3[2]=PKW(P1,12),pw3[3]=PKW(P1,14), pw3); \
    l_reg+=sacc; \
    if(GK){DMA_K((t)+3,sl_cur);} if(GV){DMA_V((t)+1,sl_next);} \
    CMASK(C0,C1,t); \
    { float a=MX3(C0[0],C0[1],C1[0]),b=MX3(C0[2],C0[3],C1[1]); a=MX3(a,C1[2],C1[3]); \
      _Pragma("unroll") for(int r=4;r<16;r+=4){a=MX3(a,C0[r],C0[r+1]);b=MX3(b,C0[r+2],C0[r+3]);a=MX3(a,C1[r],C1[r+1]);b=MX3(b,C1[r+2],C1[r+3]);} \
      float rm=__builtin_fmaxf(a,b); { auto rr=__builtin_amdgcn_permlane32_swap(__float_as_uint(rm),__float_as_uint(rm),false,false); rm=__builtin_fmaxf(__uint_as_float(rr[0]),__uint_as_float(rr[1])); } \
      resc=false; \
      if(__builtin_expect(__any(rm>(float)THRL),0)){ const float dl=__builtin_fmaxf(rm,0.f); mhat+=dl; \
        _Pragma("unroll") for(int r=0;r<16;++r){C0[r]-=dl;C1[r]-=dl;} \
        _Pragma("unroll") for(int r=0;r<16;++r)negm[r]=-mhat; asm volatile("":"+v"(negm)); \
        const float f=__builtin_amdgcn_exp2f(-dl); l_reg*=f; if(hi==0)wsf[r32]=f; resc=true; } } \
    SBAR(); \
    GAPB(o[0]=__builtin_amdgcn_mfma_f32_32x32x16_bf16(PAF(0),VFR(0),o[0],0,0,0), C0,0); \
    GAPB(o[1]=__builtin_amdgcn_mfma_f32_32x32x16_bf16(PAF(0),VFR(4),o[1],0,0,0), C0,4); \
    KRD(GL,0); GAPB(o[0]=__builtin_amdgcn_mfma_f32_32x32x16_bf16(PAF(1),VFR(1),o[0],0,0,0), C0,8); \
    KRD(GL,1); GAPB(o[1]=__builtin_amdgcn_mfma_f32_32x32x16_bf16(PAF(1),VFR(5),o[1],0,0,0), C0,12); \
    KRD(GL,2); GAPB(o[0]=__builtin_amdgcn_mfma_f32_32x32x16_bf16(PAF(2),VFR(2),o[0],0,0,0), C1,0); \
    KRD(GL,3); GAPB(o[1]=__builtin_amdgcn_mfma_f32_32x32x16_bf16(PAF(2),VFR(6),o[1],0,0,0), C1,4); \
    GAPB(o[0]=__builtin_amdgcn_mfma_f32_32x32x16_bf16(PAF(3),VFR(3),o[0],0,0,0), C1,8); \
    GAPB(o[1]=__builtin_amdgcn_mfma_f32_32x32x16_bf16(PAF(3),VFR(7),o[1],0,0,0), C1,12); \
    }while(0)
  int t=1;
  #undef CMASK
  #define CMASK(P0,P1,t) do{}while(0)
  for(;t+5<NT;t+=2){
    STEP(pB0,pB1,pA0,pA1,t,true,true,true);     WAIT_BAR(2); RESC(); ROT();
    STEP(pA0,pA1,pB0,pB1,t+1,true,true,true);   WAIT_BAR(2); RESC(); ROT();
  }
  #undef CMASK
  #define CMASK(P0,P1,t) do{int jb_=(t)-(NT-4); if(jb_>=0)cmask(P0,P1,jb_,qrel,hi);}while(0)
  #define ENDW(tt) do{ if((tt)+3<NT){WAIT_BAR(2);} else if((tt)+2<NT){WAIT_BAR(1);} else {WAIT_BAR(0);} }while(0)
  for(;t+1<NT;t+=2){
    STEP(pB0,pB1,pA0,pA1,t,(t+3<NT),(t+1<NT),(t+1<NT));       ENDW(t);   RESC(); ROT();
    STEP(pA0,pA1,pB0,pB1,t+1,(t+4<NT),(t+2<NT),(t+2<NT));     ENDW(t+1); RESC(); ROT();
  }
  STEP(pB0,pB1,pA0,pA1,NT-1,false,false,false); RESC();
  { float sacc=pB0[0]+pB0[1]; _Pragma("unroll") for(int r=2;r<16;++r)sacc+=pB0[r]; _Pragma("unroll") for(int r=0;r<16;++r)sacc+=pB1[r]; l_reg+=sacc;
    pw0=(u32x4){PKW(pB0,0),PKW(pB0,2),PKW(pB0,4),PKW(pB0,6)};pw1=(u32x4){PKW(pB0,8),PKW(pB0,10),PKW(pB0,12),PKW(pB0,14)};pw2=(u32x4){PKW(pB1,0),PKW(pB1,2),PKW(pB1,4),PKW(pB1,6)};pw3=(u32x4){PKW(pB1,8),PKW(pB1,10),PKW(pB1,12),PKW(pB1,14)};
    SBAR(); pv(o,vb0+sl_cur,PAF(0),PAF(1),PAF(2),PAF(3)); }
  #undef PKW
  #undef PAF
  #undef VFR
  #undef PIN
  #undef MX3
  #undef GAPA
  #undef GAPB
  #undef EX
  #undef VRD
  #undef KRD
  #undef STEP
  #undef ENDW
  {auto rr=__builtin_amdgcn_permlane32_swap(__float_as_uint(l_reg),__float_as_uint(l_reg),false,false);l_reg=__uint_as_float(rr[0])+__uint_as_float(rr[1]);}
  if(hi==0)wsf[32+r32]=l_reg;asm volatile("s_waitcnt lgkmcnt(0)":::"memory");
  float rli[16];
  #pragma unroll
  for(int r=0;r<16;++r)rli[r]=__builtin_amdgcn_rcpf(wsf[32+crow(r,hi)]);
  bf16*Ow=O+(rowbase+q0+wid*QBLK)*POUT;
  { bf16*stg=(bf16*)(shm+LDS_OST)+wid*2048;
    #pragma unroll
    for(int r=0;r<16;++r){const int orow=crow(r,hi);
      #pragma unroll
      for(int d0=0;d0<2;++d0)stg[orow*64+d0*32+r32]=__float2bfloat16(o[d0][r]*rli[r]);}
    asm volatile("s_waitcnt lgkmcnt(0)":::"memory");
    #pragma unroll
    for(int i=0;i<4;++i){const int row=i*8+(lane>>3),ch=lane&7; const u32x4 v=*(const u32x4*)(stg+row*64+ch*8); ATTN_STORE16(Ow+(long)row*POUT+ch*8,v);} }
  asm volatile("s_waitcnt lgkmcnt(0)\n\ts_barrier":::"memory");
  #undef DMA_K
  #undef DMA_V
  #undef CMASK
  #undef START
  #undef RESC
  #undef ROT
}
constexpr int ATTN_LDS_BYTES=LDS_BYTES;
struct AttnTensors { const bf16* Z; bf16* O; };
struct AttnUnit { int b; int vh; int qb; };
struct StaticOrder {
  int vcu,G;
  __device__ __forceinline__ explicit StaticOrder(int grid,int block):vcu((grid%8==0)?(block%8)*(grid/8)+block/8:block),G(grid){}
  __device__ __forceinline__ bool next(int i,AttnUnit&u)const{ const int item=(i>>2)*G+vcu; if(item>=256)return false; const int k=i&3; const int s=item&3; const int pr=item>>2; u.b=pr>>4; u.vh=pr&15; u.qb=(k==0)?s:(k==1)?7-s:(k==2)?8+s:15-s; return true; }
};
template<class Sched,int THRL=8> __device__ __forceinline__ void attn_phase(char*lds,const int wid,const AttnTensors&T,const Sched&S){
  AttnUnit u;
  for(int i=0;S.next(i,u);++i){
    const int h=u.vh>>2,c=(u.vh>>1)&1,half=u.vh&1;
    attn_unit<THRL>(wid,u.b,u.qb,T.Z+h*128+c*64,T.Z+512+h*128+c*64,T.Z+1024+h*128+half*64,T.O+u.vh*64,lds); }
}
#undef SBAR
#undef WAIT_BAR
}
constexpr int RING_OFF = 0, RING_BYTES = 131072;
constexpr int LDSCTL_OFF = 139264;
constexpr int MOETAB_OFF = LDSCTL_OFF + 512;
constexpr int LDS_BYTES = 147456;
constexpr int PREP_SCR_BYTES = 8 * 64 * 65 * 4;
static_assert(PREP_SCR_BYTES <= LDSCTL_OFF && MOETAB_OFF + 128 <= LDS_BYTES, "LDS map");

#define XB_TMO      128
#define XB_XCNT(j)  (256  + 64 * (j))
#define XB_XSUB(j)  (1280 + 64 * (j))
#define XB_XGEN(j)  (2304 + 64 * (j))
#define XB_TOP      3328
#define XB_TOPGEN   3392
#define XCD_BAR_WORDS 3456
#define XB_SPIN_CAP (1u << 18)
__device__ __forceinline__ unsigned xb_ld(unsigned* p)              { return __hip_atomic_load(p, __ATOMIC_RELAXED, __HIP_MEMORY_SCOPE_AGENT); }
__device__ __forceinline__ unsigned xb_add(unsigned* p, unsigned v) { return __hip_atomic_fetch_add(p, v, __ATOMIC_RELAXED, __HIP_MEMORY_SCOPE_AGENT); }
__device__ __forceinline__ unsigned xb_xcc_id() { return (unsigned)__builtin_amdgcn_s_getreg((3 << 11) | 20) & 0xFu; }
#define XB_SPIN(cond, bar) do { unsigned _sp = 0; while (cond) { __builtin_amdgcn_s_sleep(1); \
    if ((++_sp & 255u) == 0u) { if (xb_ld(&(bar)[XB_TMO])) break; if (_sp > XB_SPIN_CAP) { atomicAdd(&(bar)[XB_TMO], 1u); break; } } } } while (0)
struct XcdBarrier { unsigned* bar; unsigned x; volatile LAS unsigned* st; int wave; };
__device__ __forceinline__ XcdBarrier xcd_barrier_post(unsigned* bar, volatile LAS unsigned* st, int wave) {
    XcdBarrier b; b.bar = bar; b.x = xb_xcc_id(); b.st = st; b.wave = wave;
    if (wave == 0 && fresh_lane() == 0) (void)xb_add(&bar[XB_XCNT(b.x)], 1u);
    return b;
}
__device__ __forceinline__ void xcd_barrier_complete(unsigned* bar, unsigned x, unsigned& nloc, unsigned& nx) {
    const unsigned G = gridDim.x * gridDim.y * gridDim.z;
    unsigned sum, cnt, mine, sp = 0u;
    for (;;) {
        sum = 0u; cnt = 0u; mine = 0u;
#pragma unroll
        for (unsigned j = 0; j < 16; ++j) { const unsigned c = xb_ld(&bar[XB_XCNT(j)]); sum += c; cnt += (c > 0u) ? 1u : 0u; mine = (j == x) ? c : mine; }
        if (sum == G) break;
        __builtin_amdgcn_s_sleep(1);
        if ((++sp & 255u) == 0u) { if (xb_ld(&bar[XB_TMO])) break; if (sp > XB_SPIN_CAP) { atomicAdd(&bar[XB_TMO], 1u); break; } }
    }
    nloc = mine > 0u ? mine : 1u; nx = cnt > 0u ? cnt : 1u;
}
__device__ __forceinline__ void xcd_barrier(const XcdBarrier& b) {
    asm volatile("s_waitcnt vmcnt(0)" ::: "memory");
    __syncthreads();
    if (b.wave == 0 && fresh_lane() == 0) {
        unsigned* bar = b.bar;
        __builtin_amdgcn_s_waitcnt(0);
        unsigned nloc = b.st[0], nx = b.st[1];
        if (nloc == 0u) { xcd_barrier_complete(bar, b.x, nloc, nx); b.st[0] = nloc; b.st[1] = nx; }
        const unsigned old = xb_add(&bar[XB_XSUB(b.x)], 1u);
        const unsigned gen = old / nloc;
        if (old + 1u == (gen + 1u) * nloc) {
            __builtin_amdgcn_fence(__ATOMIC_RELEASE, "agent");
            asm volatile("s_waitcnt vmcnt(0)" ::: "memory");
            const unsigned og = xb_add(&bar[XB_TOP], 1u);
            const unsigned tg = og / nx;
            if (og + 1u == (tg + 1u) * nx) xb_add(&bar[XB_TOPGEN], 1u);
            else XB_SPIN(xb_ld(&bar[XB_TOPGEN]) == tg, bar);
            __builtin_amdgcn_fence(__ATOMIC_ACQUIRE, "agent");
            xb_add(&bar[XB_XGEN(b.x)], 1u);
            asm volatile("s_waitcnt vmcnt(0)" ::: "memory");
        } else {
            XB_SPIN(xb_ld(&bar[XB_XGEN(b.x)]) == gen, bar);
            __builtin_amdgcn_fence(__ATOMIC_ACQUIRE, "agent");
            asm volatile("s_waitcnt vmcnt(0)" ::: "memory");
        }
    }
    __syncthreads();
}

struct Args { const void* in[27]; float* out; unsigned char* ws; int ph_lo, ph_hi; };
struct Frame {
    LAS unsigned char* lds; gu32* ctl; int wave, vcu, G;
    const Args* a; unsigned char* ws; float* out;
};
#define INF(k) ((const float*)F.a->in[k])
#define WSP(T, off) ((T*)(F.ws + (off)))

struct TrJob { const float* W; const float* W3; const float* g; bf16* Wt; int K, Nsrc, Ndst, nb; size_t sstride, dstride; int gstride; };
__device__ __forceinline__ int tr_items(const TrJob& j) { return j.nb * (j.K / 64) * (j.Ndst / 64); }
__device__ __forceinline__ void tr_item(const TrJob& j, int item, LAS float* scr, int lane) {
    const int per = (j.K / 64) * (j.Ndst / 64), bi = item / per, it = item % per, nblk = j.Ndst / 64, kb = it / nblk, nbk = it % nblk, k0 = 64 * kb, n0 = 64 * nbk;
    const float* W = j.W + (size_t)bi * j.sstride; const float* W3 = j.W3 ? j.W3 + (size_t)bi * j.sstride : nullptr; bf16* Wt = j.Wt + (size_t)bi * j.dstride;
    const float* g = j.g ? j.g + (size_t)bi * j.gstride : nullptr;
    const int c4 = (lane & 15) * 4;
#pragma unroll 4
    for (int i = 0; i < 16; ++i) { const int kk = 4 * i + (lane >> 4);
        const float* src;
        if (W3) { const int g8 = c4 >> 3, half = (c4 >> 2) & 1; src = (half ? W3 : W) + (size_t)(k0 + kk) * j.Nsrc + (n0 >> 1) + g8 * 4; }
        else src = W + (size_t)(k0 + kk) * j.Nsrc + n0 + c4;
        const f32x4 v = *(const f32x4*)src; LAS float* d = scr + kk * 65 + c4; d[0] = v[0]; d[1] = v[1]; d[2] = v[2]; d[3] = v[3]; }
    LDS_WAIT(); asm volatile("" ::: "memory");
    const int c = lane & 7; float gk[8];
#pragma unroll
    for (int q = 0; q < 8; ++q) gk[q] = g ? g[k0 + 8 * c + q] : 1.f;
#pragma unroll
    for (int i = 0; i < 8; ++i) { const int n = 8 * i + (lane >> 3); const LAS float* s = scr + (8 * c) * 65 + n;
        v4u o; o.x = pk2(s[0 * 65] * gk[0], s[1 * 65] * gk[1]); o.y = pk2(s[2 * 65] * gk[2], s[3 * 65] * gk[3]); o.z = pk2(s[4 * 65] * gk[4], s[5 * 65] * gk[5]); o.w = pk2(s[6 * 65] * gk[6], s[7 * 65] * gk[7]);
        *(v4u*)(Wt + (size_t)(n0 + n) * j.K + k0 + 8 * c) = o; }
    LDS_WAIT(); asm volatile("" ::: "memory");
}
__device__ __forceinline__ void p0_prologue(Frame& F) {
    const int lane_ = fresh_lane(), tid_ = (F.wave << 6) | lane_; (void)tid_;
    LAS float* scr = (LAS float*)(F.lds + RING_OFF) + F.wave * (64 * 65);
    const int gw = F.vcu * NWAVES + F.wave, NGW = F.G * NWAVES;
    {
        TrJob J[10];
        J[0] = TrJob{INF(6), nullptr, INF(3), WSP(bf16, WS_WIN0), DM, ZW, ZW, 1, 0, 0, 0};
        J[1] = TrJob{INF(10), nullptr, nullptr, WSP(bf16, WS_WOUT0), DM, DM, DM, 1, 0, 0, 0};
        J[2] = TrJob{INF(11), INF(12), INF(4), WSP(bf16, WS_W13_0), DM, DFF, 2 * DFF, 1, 0, 0, 0};
        J[3] = TrJob{INF(13), nullptr, nullptr, WSP(bf16, WS_W2_0), DFF, DM, DM, 1, 0, 0, 0};
        J[4] = TrJob{INF(14), nullptr, INF(3) + DM, WSP(bf16, WS_WCIN), DM, 2 * DM, 2 * DM, 1, 0, 0, 0};
        J[5] = TrJob{INF(19), nullptr, nullptr, WSP(bf16, WS_WCOUT), DM, DM, DM, 1, 0, 0, 0};
        J[6] = TrJob{INF(24), nullptr, INF(5), WSP(bf16, WS_PLEG), DM, DM, DM, 2, (size_t)DM * DM, (size_t)DM * DM, DM};
        J[7] = TrJob{INF(25), nullptr, nullptr, WSP(bf16, WS_PLEP), PLE, DM, DM, 2, (size_t)PLE * DM, (size_t)PLE * DM, 0};
        J[8] = TrJob{INF(21), INF(22), INF(4) + DM, WSP(bf16, WS_M13), DM, DFF, 2 * DFF, NE, (size_t)DM * DFF, (size_t)2 * DFF * DM, 0};
        J[9] = TrJob{INF(23), nullptr, nullptr, WSP(bf16, WS_M2), DFF, DM, DM, NE, (size_t)DFF * DM, (size_t)DM * DFF, 0};
        int base = 0;
#pragma unroll
        for (int q = 0; q < 10; ++q) { const int n = tr_items(J[q]);
            int first = gw - (base % NGW); if (first < 0) first += NGW;
            for (int it = first; it < n; it += NGW) tr_item(J[q], it, scr, lane_);
            base += n; }
    }
    const float* x = INF(0); bf16* HB = WSP(bf16, WS_HB); float* ssa = WSP(float, WS_SSA); float* tab = WSP(float, WS_TAB);
    const int* pos = (const int*)F.a->in[2];
    for (int m = gw; m < NTOK; m += NGW) {
        const f32x4* xr = (const f32x4*)(x + (size_t)m * DM) + lane_; float q = 0.f; f32x4 v[4];
#pragma unroll
        for (int j = 0; j < 4; ++j) { v[j] = xr[64 * j]; q += (v[j][0] * v[j][0] + v[j][1] * v[j][1]) + (v[j][2] * v[j][2] + v[j][3] * v[j][3]); }
        q = wave_sum(q);
        v2u* o = (v2u*)(HB + (size_t)m * DM) + lane_;
#pragma unroll
        for (int j = 0; j < 4; ++j) { v2u w; w.x = pk2(v[j][0], v[j][1]); w.y = pk2(v[j][2], v[j][3]); o[64 * j] = w; }
        if (lane_ < 16) ssa[(size_t)m * 16 + lane_] = (lane_ == 0) ? q : 0.f;
        if (lane_ < 16) { const int i = lane_ & 7; const float inv = powf(500000.0f, -(float)(2 * i) / 16.0f); const float ang = (float)pos[m] * inv;
            tab[(size_t)m * 16 + lane_] = (lane_ < 8) ? cosf(ang) : sinf(ang); }
    }
    {
        const float* p = INF(1); bf16* pb0 = (bf16*)F.out; bf16* pb1 = WSP(bf16, WS_PB1);
        const long n8 = (long)NTOK * PLE / 8;
        for (long i = (long)gw * 64 + lane_; i < 2 * n8; i += (long)NGW * 64) {
            const f32x4 a = *(const f32x4*)(p + i * 8), b = *(const f32x4*)(p + i * 8 + 4);
            v4u w; w.x = pk2(a[0], a[1]); w.y = pk2(a[2], a[3]); w.z = pk2(b[0], b[1]); w.w = pk2(b[2], b[3]);
            if (i < n8) *(v4u*)(pb0 + i * 8) = w; else *(v4u*)(pb1 + (i - n8) * 8) = w; }
    }
    {
        const float* ws_ = INF(17); bf16* wt = WSP(bf16, WS_WTRIL);
        for (int i = gw * 64 + lane_; i < 8 * 128 * 128; i += NGW * 64) { const int t = (i >> 7) & 127, s = i & 127; wt[i] = (bf16)(pk2(s <= t ? ws_[i] : 0.f, 0.f) & 0xffffu); }
    }
}

__device__ __forceinline__ void mix_phase(Frame& F) {
    const int lane_ = fresh_lane(), tid_ = (F.wave << 6) | lane_; (void)tid_;
    const int gw = F.vcu * NWAVES + F.wave, NGW = F.G * NWAVES, l = lane_;
    const float* lp = INF(7);
    const float s01 = wave_sum(lp[l] * lp[64 + l]), s23 = wave_sum(lp[128 + l] * lp[192 + l]);
    const float lam = expf(s01) - expf(s23) + 0.2f;
    const bf16* AT = WSP(bf16, WS_AT); const bf16* Z = WSP(bf16, WS_Z); bf16* AO = WSP(bf16, WS_AO);
    const float* subln = INF(8); const float* cw = INF(9);
    const int h = l >> 4, e0 = (l & 15) * 8, ch0 = l * 8;
    float sg[8], w0[8], w1[8], w2[8];
#pragma unroll
    for (int j = 0; j < 8; ++j) { sg[j] = subln[e0 + j] * 0.8f; w0[j] = cw[(ch0 + j) * 3 + 0]; w1[j] = cw[(ch0 + j) * 3 + 1]; w2[j] = cw[(ch0 + j) * 3 + 2]; }
    for (int m = gw; m < NTOK; m += NGW) {
        float o1[8], o2[8], a[8]; unpk8(*(const v4u*)(AT + (size_t)m * DM + h * 256 + e0), o1); unpk8(*(const v4u*)(AT + (size_t)m * DM + h * 256 + 128 + e0), o2);
        float q = 0.f;
#pragma unroll
        for (int j = 0; j < 8; ++j) { a[j] = o1[j] - lam * o2[j]; q += a[j] * a[j]; }
        q += __shfl_xor(q, 1); q += __shfl_xor(q, 2); q += __shfl_xor(q, 4); q += __shfl_xor(q, 8);
        const float r = 1.0f / sqrtf(q * (1.0f / 128.0f) + RMS_EPS);
#pragma unroll
        for (int j = 0; j < 8; ++j) a[j] = a[j] * r * sg[j];
        *(v4u*)(AO + (size_t)m * DM + h * 128 + e0) = pk8(a);
        const int t = m & (SEQ - 1);
        float bg[8], cg[8], hc[8], acc[8];
        unpk8(*(const v4u*)(Z + (size_t)m * ZW + 1536 + ch0), bg);
        unpk8(*(const v4u*)(Z + (size_t)m * ZW + 2048 + ch0), cg); unpk8(*(const v4u*)(Z + (size_t)m * ZW + 2560 + ch0), hc);
#pragma unroll
        for (int j = 0; j < 8; ++j) acc[j] = w2[j] * cg[j] * hc[j];
        if (t >= 1) { unpk8(*(const v4u*)(Z + (size_t)(m - 1) * ZW + 2048 + ch0), cg); unpk8(*(const v4u*)(Z + (size_t)(m - 1) * ZW + 2560 + ch0), hc);
#pragma unroll
            for (int j = 0; j < 8; ++j) acc[j] += w1[j] * cg[j] * hc[j]; }
        if (t >= 2) { unpk8(*(const v4u*)(Z + (size_t)(m - 2) * ZW + 2048 + ch0), cg); unpk8(*(const v4u*)(Z + (size_t)(m - 2) * ZW + 2560 + ch0), hc);
#pragma unroll
            for (int j = 0; j < 8; ++j) acc[j] += w0[j] * cg[j] * hc[j]; }
#pragma unroll
        for (int j = 0; j < 8; ++j) acc[j] *= bg[j];
        *(v4u*)(AO + (size_t)m * DM + 512 + ch0) = pk8(acc);
    }
}
__device__ __forceinline__ void stat_ss_phase(Frame& F, float* ss) {
    const int lane_ = fresh_lane(), tid_ = (F.wave << 6) | lane_; (void)tid_;
    const int gw = F.vcu * NWAVES + F.wave, NGW = F.G * NWAVES;
    for (int m = gw; m < NTOK; m += NGW) {
        const f32x4* xr = (const f32x4*)(F.out + (size_t)m * DM) + lane_; float q = 0.f;
#pragma unroll
        for (int j = 0; j < 4; ++j) { const f32x4 v = xr[64 * j]; q += (v[0] * v[0] + v[1] * v[1]) + (v[2] * v[2] + v[3] * v[3]); }
        q = wave_sum(q);
        if (lane_ < 16) ss[(size_t)m * 16 + lane_] = (lane_ == 0) ? q : 0.f;
    }
}
__device__ __forceinline__ void stat_ln_phase(Frame& F) {
    const int lane_ = fresh_lane(), tid_ = (F.wave << 6) | lane_; (void)tid_;
    const int gw = F.vcu * NWAVES + F.wave, NGW = F.G * NWAVES; const bf16* UV = WSP(bf16, WS_UV); float* lns = WSP(float, WS_LNS); float* lnq = WSP(float, WS_LNQ);
    for (int m = gw; m < NTOK; m += NGW) {
        float v[8], a[8]; unpk8(*(const v4u*)(UV + (size_t)m * 2048 + 1024 + lane_ * 8), v); unpk8(*(const v4u*)(UV + (size_t)m * 2048 + 1536 + lane_ * 8), a);
        float s = 0.f, q = 0.f;
#pragma unroll
        for (int j = 0; j < 8; ++j) { s += v[j] + a[j]; q += v[j] * v[j] + a[j] * a[j]; }
        s = wave_sum(s); q = wave_sum(q);
        if (lane_ < 16) { lns[(size_t)m * 16 + lane_] = (lane_ == 0) ? s : 0.f; lnq[(size_t)m * 16 + lane_] = (lane_ == 0) ? q : 0.f; }
    }
}
__device__ __forceinline__ void sgate_naive_phase(Frame& F) {
    const int lane_ = fresh_lane(), tid_ = (F.wave << 6) | lane_; (void)tid_;
    const bf16* UV = WSP(bf16, WS_UV); bf16* SG = WSP(bf16, WS_SG); const float* lns = WSP(float, WS_LNS); const float* lnq = WSP(float, WS_LNQ);
    const float* lg = INF(15); const float* lb = INF(16); const float* W = INF(17); const float* bs = INF(18);
    const long nitem = (long)NTOK * 128;
    for (long it = (long)blockIdx.x * NTHREADS + tid_; it < nitem; it += (long)F.G * NTHREADS) {
        const int row = (int)(it >> 7), c8 = (int)(it & 127) * 8, g = c8 >> 7, tl = row & 127, r0 = row - tl;
        float gg[8], bb[8], acc[8];
#pragma unroll
        for (int j = 0; j < 8; ++j) { gg[j] = lg[c8 + j]; bb[j] = lb[c8 + j]; acc[j] = 0.f; }
        for (int sl = 0; sl <= tl; ++sl) {
            const int rs = r0 + sl; const float mu = sum16(lns + (size_t)rs * 16) * (1.0f / DM), var = sum16(lnq + (size_t)rs * 16) * (1.0f / DM) - mu * mu, rstd = 1.0f / sqrtf(var + LN_EPS);
            float v[8]; unpk8(*(const v4u*)(UV + (size_t)rs * 2048 + 1024 + c8), v);
            const float w = W[(g * 128 + tl) * 128 + sl];
#pragma unroll
            for (int j = 0; j < 8; ++j) acc[j] += w * ((v[j] - mu) * rstd * gg[j] + bb[j]);
        }
        float u[8]; unpk8(*(const v4u*)(UV + (size_t)row * 2048 + c8), u);
        const float b0 = bs[g * 128 + tl];
#pragma unroll
        for (int j = 0; j < 8; ++j) acc[j] = u[j] * (acc[j] + b0);
        *(v4u*)(SG + (size_t)row * DM + c8) = pk8(acc);
    }
}
__device__ __forceinline__ void router_phase(Frame& F) {
    const int lane_ = fresh_lane(), tid_ = (F.wave << 6) | lane_; (void)tid_;
    LAS int* sE = (LAS int*)(F.lds + RING_OFF); LAS float* sG = (LAS float*)(F.lds + RING_OFF + 1024); LAS float* sR = (LAS float*)(F.lds + RING_OFF + 2048);
    const float* ssa = WSP(float, WS_SSA); const float* gw_ = INF(4) + DM; const float* rw = INF(20);
    int* mtok = WSP(int, WS_MTOK); float* mscl = WSP(float, WS_MSCL); float* mgate = WSP(float, WS_MGATE); int* mslot = WSP(int, WS_MSLOT);
    for (int tb = blockIdx.x; tb < NTOK / 64; tb += F.G) {
        for (int i = 0; i < 8; ++i) {
            const int lt = F.wave * 8 + i, row = tb * 64 + lt; const float r = rscale16(ssa, row);
            float lg[8];
#pragma unroll
            for (int e = 0; e < 8; ++e) lg[e] = 0.f;
#pragma unroll
            for (int j = 0; j < 4; ++j) { const int k0 = lane_ * 4 + 256 * j; const f32x4 hv = *(const f32x4*)(F.out + (size_t)row * DM + k0), gv = *(const f32x4*)(gw_ + k0);
#pragma unroll
                for (int q = 0; q < 4; ++q) { const float hn = hv[q] * r * gv[q]; const f32x4 w0 = *(const f32x4*)(rw + (size_t)(k0 + q) * 8), w1 = *(const f32x4*)(rw + (size_t)(k0 + q) * 8 + 4);
                    lg[0] += hn * w0[0]; lg[1] += hn * w0[1]; lg[2] += hn * w0[2]; lg[3] += hn * w0[3]; lg[4] += hn * w1[0]; lg[5] += hn * w1[1]; lg[6] += hn * w1[2]; lg[7] += hn * w1[3]; } }
#pragma unroll
            for (int e = 0; e < 8; ++e) lg[e] = wave_sum(lg[e]);
            if (lane_ == 0) {
                int e0 = 0; float v0 = lg[0];
#pragma unroll
                for (int e = 1; e < 8; ++e) if (lg[e] > v0) { v0 = lg[e]; e0 = e; }
                int e1 = -1; float v1 = -INFINITY;
#pragma unroll
                for (int e = 0; e < 8; ++e) if (e != e0 && lg[e] > v1) { v1 = lg[e]; e1 = e; }
                const float g0 = 1.0f / (1.0f + expf(v1 - v0));
                sE[lt * 2] = e0; sE[lt * 2 + 1] = e1; sG[lt * 2] = g0; sG[lt * 2 + 1] = 1.0f - g0; sR[lt] = r;
            }
        }
        __syncthreads();
        if (tid_ < 8) {
            const int e = tid_; int c = 0;
            for (int q = 0; q < 128; ++q) c += (sE[q] == e) ? 1 : 0;
            if (c > 0) {
                int pos = (int)__hip_atomic_fetch_add((unsigned*)(F.ctl + CW_CNT + 64 * e), (unsigned)c, RLX_AGENT);
                for (int q = 0; q < 128; ++q) if (sE[q] == e) { const int tok = tb * 64 + (q >> 1);
                    mtok[e * NTOK + pos] = tok; mscl[e * NTOK + pos] = sR[q >> 1]; mgate[e * NTOK + pos] = sG[q]; mslot[tok * 2 + (q & 1)] = (e << 16) | pos; ++pos; }
            }
        }
        __syncthreads();
    }
}
__device__ __forceinline__ void moe_tab(Frame& F) {
    const int lane_ = fresh_lane(), tid_ = (F.wave << 6) | lane_; (void)tid_;
    LAS int* tab = (LAS int*)(F.lds + MOETAB_OFF);
    if (tid_ == 0) { int tp = 0, rb = 0;
        for (int e = 0; e < 8; ++e) { const int c = (int)__hip_atomic_load((unsigned*)(F.ctl + CW_CNT + 64 * e), RLX_AGENT); tab[e] = tp; tab[9 + e] = rb; tab[18 + e] = c; tp += (c + 255) >> 8; rb += c; }
        tab[8] = tp; tab[17] = rb; }
    __syncthreads();
}
__device__ __forceinline__ void combine_phase(Frame& F) {
    const int lane_ = fresh_lane(), tid_ = (F.wave << 6) | lane_; (void)tid_;
    const int gw = F.vcu * NWAVES + F.wave, NGW = F.G * NWAVES;
    const LAS int* tab = (const LAS int*)(F.lds + MOETAB_OFF);
    const int* mslot = WSP(int, WS_MSLOT); const bf16* Y = WSP(bf16, WS_Y); bf16* HB2 = WSP(bf16, WS_HB2); float* ssb = WSP(float, WS_SSB);
    for (int m = gw; m < NTOK; m += NGW) {
        const int s0 = mslot[m * 2], s1 = mslot[m * 2 + 1];
        const size_t y0 = (size_t)(tab[9 + (s0 >> 16)] + (s0 & 0xffff)), y1 = (size_t)(tab[9 + (s1 >> 16)] + (s1 & 0xffff));
        float q = 0.f;
#pragma unroll
        for (int j = 0; j < 2; ++j) { const int c = lane_ * 8 + 512 * j; const size_t off = (size_t)m * DM + c;
            const f32x4 h0 = *(const f32x4*)(F.out + off), h1 = *(const f32x4*)(F.out + off + 4);
            float a[8], b[8]; unpk8(*(const v4u*)(Y + y0 * DM + c), a); unpk8(*(const v4u*)(Y + y1 * DM + c), b);
            float o[8] = {h0[0], h0[1], h0[2], h0[3], h1[0], h1[1], h1[2], h1[3]};
#pragma unroll
            for (int k = 0; k < 8; ++k) { o[k] += a[k] + b[k]; q += o[k] * o[k]; }
            *(f32x4*)(F.out + off) = (f32x4){o[0], o[1], o[2], o[3]}; *(f32x4*)(F.out + off + 4) = (f32x4){o[4], o[5], o[6], o[7]};
            *(v4u*)(HB2 + off) = pk8(o); }
        q = wave_sum(q);
        if (lane_ < 16) ssb[(size_t)m * 16 + lane_] = (lane_ == 0) ? q : 0.f;
    }
}
__device__ __forceinline__ void final_phase(Frame& F) {
    const int lane_ = fresh_lane(), tid_ = (F.wave << 6) | lane_; (void)tid_;
    const int gw = F.vcu * NWAVES + F.wave, NGW = F.G * NWAVES; const float* ssa = WSP(float, WS_SSA); const float* fn = INF(26);
    f32x4 g[4];
#pragma unroll
    for (int j = 0; j < 4; ++j) g[j] = *((const f32x4*)fn + lane_ + 64 * j);
    for (int m = gw; m < NTOK; m += NGW) { const float r = rscale16(ssa, m); f32x4* xr = (f32x4*)(F.out + (size_t)m * DM) + lane_;
#pragma unroll
        for (int j = 0; j < 4; ++j) { f32x4 v = xr[64 * j]; v = v * r * g[j]; xr[64 * j] = v; } }
}
__device__ __forceinline__ void attn_naive_phase(Frame& F) {
    const int lane_ = fresh_lane(), tid_ = (F.wave << 6) | lane_; (void)tid_;
    const bf16* Z = WSP(bf16, WS_Z); bf16* AT = WSP(bf16, WS_AT);
    const long nitem = (long)BATCH * 16 * SEQ;
    for (long it = (long)blockIdx.x * NTHREADS + tid_; it < nitem; it += (long)F.G * NTHREADS) {
        const int q = (int)(it % SEQ), bv = (int)(it / SEQ), vh = bv & 15, b = bv >> 4, h = vh >> 2, c = (vh >> 1) & 1, half = vh & 1;
        const size_t row = (size_t)b * SEQ + q;
        float qv[64], o[64];
#pragma unroll
        for (int d = 0; d < 64; d += 8) { float t[8]; unpk8(*(const v4u*)(Z + row * ZW + h * 128 + c * 64 + d), t);
#pragma unroll
            for (int j = 0; j < 8; ++j) { qv[d + j] = t[j]; o[d + j] = 0.f; } }
        float mx = -INFINITY, l = 0.f;
        const bf16* kp = Z + (size_t)b * SEQ * ZW + 512 + h * 128 + c * 64; const bf16* vp = Z + (size_t)b * SEQ * ZW + 1024 + h * 128 + half * 64;
        for (int j = 0; j <= q; ++j) {
            float s = 0.f;
#pragma unroll
            for (int d = 0; d < 64; d += 8) { float t[8]; unpk8(*(const v4u*)(kp + (size_t)j * ZW + d), t);
#pragma unroll
                for (int k = 0; k < 8; ++k) s += qv[d + k] * t[k]; }
            const float mn = fmaxf(mx, s), corr = exp2f(mx - mn), p = exp2f(s - mn); l = l * corr + p; mx = mn;
#pragma unroll
            for (int d = 0; d < 64; d += 8) { float t[8]; unpk8(*(const v4u*)(vp + (size_t)j * ZW + d), t);
#pragma unroll
                for (int k = 0; k < 8; ++k) o[d + k] = o[d + k] * corr + p * t[k]; }
        }
        const float il = 1.0f / l;
#pragma unroll
        for (int d = 0; d < 64; d += 8) { float t[8];
#pragma unroll
            for (int k = 0; k < 8; ++k) t[k] = o[d + k] * il;
            *(v4u*)(AT + row * DM + vh * 64 + d) = pk8(t); }
    }
}
enum Phase { PH_PREP = 0, PH_Z, PH_ATTN, PH_MIX, PH_OUT, PH_ST1, PH_FUP, PH_FDN, PH_ST2, PH_PLE0, PH_ST3, PH_CIN, PH_ST4, PH_SG, PH_COUT, PH_ST5, PH_ROUTER, PH_MUP, PH_MDN, PH_COMB, PH_PLE1, PH_ST6, PH_FINAL, NPH };
constexpr bool NAIVE_G = (NAIVE_MASK & NV_GEMM) != 0, NAIVE_A = (NAIVE_MASK & NV_ATTN) != 0, NAIVE_S = (NAIVE_MASK & NV_SGATE) != 0;
__host__ __device__ constexpr bool phase_on(int p) { return (p == PH_ST1 || p == PH_ST2 || p == PH_ST3 || p == PH_ST4 || p == PH_ST5 || p == PH_ST6) ? NAIVE_G : true; }

template <class Epi, class Sched, bool GATHER>
__device__ __forceinline__ void run_gemm(Frame& F, const pg8::Gemm& g, const Sched& S, const Epi& E) {
    if constexpr (NAIVE_G) pg8::naive_gemm_phase<Epi, Sched>(F.lds + RING_OFF, F.wave, g, S, E);
    else pg8::gemm_phase<Epi, Sched, GATHER, true>(F.lds + RING_OFF, F.wave, g, S, E);
}

__global__ void __launch_bounds__(NTHREADS, 2) fwd_kernel(Args args) {
    extern __shared__ __attribute__((aligned(16))) unsigned char lds[];
    Frame F;
    F.lds = (LAS unsigned char*)lds; F.a = &args; F.ws = args.ws; F.out = args.out;
    F.wave = __builtin_amdgcn_readfirstlane((int)threadIdx.x >> 6);
    F.G = gridDim.x; { const int bx = blockIdx.x; F.vcu = (F.G % 8 == 0) ? (bx % 8) * (F.G / 8) + bx / 8 : bx; }
    F.ctl = (gu32*)(args.ws + WS_CTL);
    if (F.wave == 0) ((LAS unsigned*)(F.lds + LDSCTL_OFF))[fresh_lane()] = 0u;
    __syncthreads();
    const int lo = args.ph_lo, hi = args.ph_hi;
    XcdBarrier bar; bar.bar = (unsigned*)(F.ctl + CW_BAR); bar.x = 0; bar.st = nullptr; bar.wave = F.wave;
    if (hi - lo > 1) bar = xcd_barrier_post((unsigned*)(F.ctl + CW_BAR), (volatile LAS unsigned*)(F.lds + LDSCTL_OFF) + 8, F.wave);
    const int cid = (int)blockIdx.x;
#define SEAM(k) do { bool more_ = false; for (int p_ = (k) + 1; p_ < hi; ++p_) more_ = more_ || phase_on(p_); if (more_) xcd_barrier(bar); } while (0)
#ifdef ONLY_PHASE
#define IN(k) ((k) == ONLY_PHASE && phase_on(k) && lo <= (k) && (k) < hi)
#else
#define IN(k) (phase_on(k) && lo <= (k) && (k) < hi)
#endif

    if (IN(PH_PREP)) { p0_prologue(F); SEAM(PH_PREP); }

    if (IN(PH_Z)) {
        { pg8::Gemm g{WSP(bf16, WS_HB), WSP(bf16, WS_WIN0), 0, DM, nullptr}; pg8::StaticOrder S; S.init(NTOK, ZW, F.G, cid);
          epi::EpiZ E{WSP(bf16, WS_Z), WSP(float, WS_SSA), WSP(float, WS_TAB)}; run_gemm<epi::EpiZ, pg8::StaticOrder, false>(F, g, S, E); }
        { pg8::Gemm g{(const bf16*)F.out, WSP(bf16, WS_PLEP), 0, PLE, nullptr}; pg8::StaticOrder S; S.init(NTOK, DM, F.G, cid);
          epi::EpiStore<false> E{WSP(bf16, WS_PP), nullptr}; run_gemm<epi::EpiStore<false>, pg8::StaticOrder, false>(F, g, S, E); }
        SEAM(PH_Z);
    }
    if (IN(PH_ATTN)) {
        if constexpr (NAIVE_A) attn_naive_phase(F);
        else { const attn_body::AttnTensors AT{(const attn_body::bf16*)WSP(bf16, WS_Z), (attn_body::bf16*)WSP(bf16, WS_AT)}; const attn_body::StaticOrder S(F.G, cid);
               attn_body::attn_phase<attn_body::StaticOrder>((char*)lds + RING_OFF, F.wave, AT, S); }
        SEAM(PH_ATTN);
    }
    if (IN(PH_MIX)) { mix_phase(F); SEAM(PH_MIX); }
    if (IN(PH_OUT)) {
        pg8::Gemm g{WSP(bf16, WS_AO), WSP(bf16, WS_WOUT0), 0, DM, nullptr}; pg8::StaticOrder S; S.init(NTOK, DM, F.G, cid);
        epi::EpiRes<0> E{INF(0), F.out, WSP(bf16, WS_HB), WSP(float, WS_SSB), nullptr, nullptr}; run_gemm<epi::EpiRes<0>, pg8::StaticOrder, false>(F, g, S, E);
        SEAM(PH_OUT);
    }
    if (IN(PH_ST1)) { stat_ss_phase(F, WSP(float, WS_SSB)); SEAM(PH_ST1); }
    if (IN(PH_FUP)) {
        pg8::Gemm g{WSP(bf16, WS_HB), WSP(bf16, WS_W13_0), 0, DM, nullptr}; pg8::StaticOrder S; S.init(NTOK, 2 * DFF, F.G, cid);
        epi::EpiGlu<false> E{WSP(bf16, WS_ACT0), WSP(float, WS_SSB)}; run_gemm<epi::EpiGlu<false>, pg8::StaticOrder, false>(F, g, S, E);
        SEAM(PH_FUP);
    }
    if (IN(PH_FDN)) {
        pg8::Gemm g{WSP(bf16, WS_ACT0), WSP(bf16, WS_W2_0), 0, DFF, nullptr}; pg8::StaticOrder S; S.init(NTOK, DM, F.G, cid);
        epi::EpiRes<0> E{F.out, F.out, WSP(bf16, WS_HB), WSP(float, WS_SSA), nullptr, nullptr}; run_gemm<epi::EpiRes<0>, pg8::StaticOrder, false>(F, g, S, E);
        SEAM(PH_FDN);
    }
    if (IN(PH_ST2)) { stat_ss_phase(F, WSP(float, WS_SSA)); SEAM(PH_ST2); }
    if (IN(PH_PLE0)) {
        pg8::Gemm g{WSP(bf16, WS_HB), WSP(bf16, WS_PLEG), 0, DM, nullptr}; pg8::StaticOrder S; S.init(NTOK, DM, F.G, cid);
        epi::EpiRes<2> E{F.out, F.out, WSP(bf16, WS_HB3), WSP(float, WS_SSB), WSP(float, WS_SSA), WSP(bf16, WS_PP)}; run_gemm<epi::EpiRes<2>, pg8::StaticOrder, false>(F, g, S, E);
        SEAM(PH_PLE0);
    }
    if (IN(PH_ST3)) { stat_ss_phase(F, WSP(float, WS_SSB)); SEAM(PH_ST3); }
    if (IN(PH_CIN)) {
        pg8::Gemm g{WSP(bf16, WS_HB3), WSP(bf16, WS_WCIN), 0, DM, nullptr}; pg8::StaticOrder S; S.init(NTOK, 2 * DM, F.G, cid);
        epi::EpiGelu E{WSP(bf16, WS_UV), WSP(float, WS_SSB), WSP(float, WS_LNS), WSP(float, WS_LNQ)}; run_gemm<epi::EpiGelu, pg8::StaticOrder, false>(F, g, S, E);
        SEAM(PH_CIN);
    }
    if (IN(PH_ST4)) { stat_ln_phase(F); SEAM(PH_ST4); }
    if (IN(PH_SG)) { sgate_naive_phase(F); SEAM(PH_SG); }
    if (IN(PH_COUT)) {
        pg8::Gemm g{WSP(bf16, WS_SG), WSP(bf16, WS_WCOUT), 0, DM, nullptr}; pg8::StaticOrder S; S.init(NTOK, DM, F.G, cid);
        epi::EpiRes<0> E{F.out, F.out, WSP(bf16, WS_HB), WSP(float, WS_SSA), nullptr, nullptr}; run_gemm<epi::EpiRes<0>, pg8::StaticOrder, false>(F, g, S, E);
        SEAM(PH_COUT);
    }
    if (IN(PH_ST5)) { stat_ss_phase(F, WSP(float, WS_SSA)); SEAM(PH_ST5); }
    if (IN(PH_ROUTER)) { router_phase(F); SEAM(PH_ROUTER); }
    if (IN(PH_MUP)) {
        moe_tab(F);
        pg8::Gemm g{WSP(bf16, WS_HB), WSP(bf16, WS_M13), (size_t)2 * DFF * DM, DM, WSP(int, WS_MTOK)}; pg8::MoeOrder S; S.init((const LAS int*)(F.lds + MOETAB_OFF), 2 * DFF, F.G, cid);
        epi::EpiGlu<true> E{WSP(bf16, WS_ACTM), WSP(float, WS_MSCL)}; run_gemm<epi::EpiGlu<true>, pg8::MoeOrder, true>(F, g, S, E);
        SEAM(PH_MUP);
    }
    if (IN(PH_MDN)) {
        moe_tab(F);
        pg8::Gemm g{WSP(bf16, WS_ACTM), WSP(bf16, WS_M2), (size_t)DM * DFF, DFF, nullptr}; pg8::MoeOrder S; S.init((const LAS int*)(F.lds + MOETAB_OFF), DM, F.G, cid);
        epi::EpiStore<true> E{WSP(bf16, WS_Y), WSP(float, WS_MGATE)}; run_gemm<epi::EpiStore<true>, pg8::MoeOrder, false>(F, g, S, E);
        SEAM(PH_MDN);
    }
    if (IN(PH_COMB)) {
        moe_tab(F);
        combine_phase(F);
        { pg8::Gemm g{WSP(bf16, WS_PB1), WSP(bf16, WS_PLEP) + (size_t)DM * PLE, 0, PLE, nullptr}; pg8::StaticOrder S; S.init(NTOK, DM, F.G, cid);
          epi::EpiStore<false> E{WSP(bf16, WS_PP2), nullptr}; run_gemm<epi::EpiStore<false>, pg8::StaticOrder, false>(F, g, S, E); }
        SEAM(PH_COMB);
    }
    if (IN(PH_PLE1)) {
        pg8::Gemm g{WSP(bf16, WS_HB2), WSP(bf16, WS_PLEG) + (size_t)DM * DM, 0, DM, nullptr}; pg8::StaticOrder S; S.init(NTOK, DM, F.G, cid);
        epi::EpiRes<2> E{F.out, F.out, WSP(bf16, WS_HB), WSP(float, WS_SSA), WSP(float, WS_SSB), WSP(bf16, WS_PP2)}; run_gemm<epi::EpiRes<2>, pg8::StaticOrder, false>(F, g, S, E);
        SEAM(PH_PLE1);
    }
    if (IN(PH_ST6)) { stat_ss_phase(F, WSP(float, WS_SSA)); SEAM(PH_ST6); }
    if (IN(PH_FINAL)) { final_phase(F); }
#undef IN
#undef SEAM
}

extern "C" void kernel_launch(void* const* d_in, const int* in_sizes, int n_in, void* d_out, int out_size, void* d_ws, size_t ws_size, hipStream_t stream) {
    static int grid = 0;
    if (grid == 0) {
        if (n_in != 27 || in_sizes[0] != NTOK * DM || out_size != NTOK * DM || ws_size < WS_END) { fprintf(stderr, "kernel_launch: unexpected problem (n_in %d, in0 %d, out %d, ws %zu < %zu); nothing launched\n", n_in, n_in > 0 ? in_sizes[0] : -1, out_size, ws_size, (size_t)WS_END); grid = -1; return; }
        int dev = 0, cus = 0, per_cu = 0;
        if (hipGetDevice(&dev) != hipSuccess || hipDeviceGetAttribute(&cus, hipDeviceAttributeMultiprocessorCount, dev) != hipSuccess) { grid = -1; return; }
        if (hipFuncSetAttribute((const void*)fwd_kernel, hipFuncAttributeMaxDynamicSharedMemorySize, LDS_BYTES) != hipSuccess) { fprintf(stderr, "kernel_launch: hipFuncSetAttribute failed\n"); grid = -1; return; }
        if (hipOccupancyMaxActiveBlocksPerMultiprocessor(&per_cu, (const void*)fwd_kernel, NTHREADS, LDS_BYTES) != hipSuccess || per_cu < 1)
            fprintf(stderr, "kernel_launch: note: occupancy query reports %d workgroups per CU\n", per_cu);
        (void)hipGetLastError();
        grid = cus;
    }
    if (grid < 0) return;
    if (hipMemsetAsync((char*)d_ws + WS_CTL, 0, CTL_ZERO_BYTES, stream) != hipSuccess) return;
    Args a{};
    for (int i = 0; i < 27; ++i) a.in[i] = d_in[i];
    a.out = (float*)d_out; a.ws = (unsigned char*)d_ws;
    if (MK_N_LAUNCHES == 1) { a.ph_lo = 0; a.ph_hi = NPH; hipLaunchKernelGGL(fwd_kernel, dim3(grid), dim3(NTHREADS), LDS_BYTES, stream, a); }
    else for (int p = 0; p < NPH; ++p) { if (!phase_on(p)) continue; a.ph_lo = p; a.ph_hi = p + 1; hipLaunchKernelGGL(fwd_kernel, dim3(grid), dim3(NTHREADS), LDS_BYTES, stream, a); }
}
```

```cpp
#include <hip/hip_runtime.h>
#include <hip/hip_bf16.h>
#include <cstdio>
#include <cstdint>
#include <cmath>

#ifndef MK_N_LAUNCHES
#define MK_N_LAUNCHES 1
#endif
#define NV_GEMM   1u
#define NV_ATTN   2u
#define NV_SGATE  4u
#ifndef NAIVE_MASK
#define NAIVE_MASK 0u
#endif

#define GAS __attribute__((address_space(1)))
#define LAS __attribute__((address_space(3)))
typedef unsigned short bf16;
typedef unsigned v4u __attribute__((ext_vector_type(4)));
typedef unsigned v2u __attribute__((ext_vector_type(2)));
typedef float f32x4 __attribute__((ext_vector_type(4)));
typedef float f32x2 __attribute__((ext_vector_type(2)));
typedef short bf16x8 __attribute__((ext_vector_type(8)));
typedef GAS unsigned gu32;
#define RLX_AGENT __ATOMIC_RELAXED, __HIP_MEMORY_SCOPE_AGENT
#define LDS_WAIT() asm volatile("s_waitcnt lgkmcnt(0)" ::: "memory")
#define VM_WAIT() asm volatile("s_waitcnt vmcnt(0)" ::: "memory")

constexpr int BATCH = 4, SEQ = 4096, NTOK = BATCH * SEQ, DM = 1024, PLE = 256, DFF = 2816, NE = 8, ZW = 3072;
constexpr int NWAVES = 8, NTHREADS = 512;
constexpr float RMS_EPS = 1e-6f, LN_EPS = 1e-5f;
constexpr float ATT_C2 = 0.125f * 1.4426950408889634f;

constexpr size_t MiB = 1u << 20;
constexpr size_t WS_CTL = 0, CTL_ZERO_BYTES = 1 * MiB;
constexpr size_t WS_TAB = 1 * MiB;
constexpr size_t WS_SSA = 2 * MiB, WS_SSB = 3 * MiB;
constexpr size_t WS_LNS = 4 * MiB, WS_LNQ = 5 * MiB;
constexpr size_t WS_MTOK = 6 * MiB;
constexpr size_t WS_MSCL = WS_MTOK + 512 * 1024;
constexpr size_t WS_MGATE = 7 * MiB;
constexpr size_t WS_MSLOT = WS_MGATE + 512 * 1024;
constexpr size_t WS_WTRIL = WS_MSLOT + 128 * 1024;
constexpr size_t WS_W = 8 * MiB;
constexpr size_t WS_WIN0 = WS_W;
constexpr size_t WS_WOUT0 = WS_WIN0 + (size_t)ZW * DM * 2;
constexpr size_t WS_W13_0 = WS_WOUT0 + (size_t)DM * DM * 2;
constexpr size_t WS_W2_0 = WS_W13_0 + (size_t)2 * DFF * DM * 2;
constexpr size_t WS_WCIN = WS_W2_0 + (size_t)DM * DFF * 2;
constexpr size_t WS_WCOUT = WS_WCIN + (size_t)2 * DM * DM * 2;
constexpr size_t WS_PLEG = WS_WCOUT + (size_t)DM * DM * 2;
constexpr size_t WS_PLEP = WS_PLEG + (size_t)2 * DM * DM * 2;
constexpr size_t WS_M13 = WS_PLEP + (size_t)2 * DM * PLE * 2;
constexpr size_t WS_M2 = WS_M13 + (size_t)NE * 2 * DFF * DM * 2;
constexpr size_t WS_WEND = WS_M2 + (size_t)NE * DM * DFF * 2;
constexpr size_t WS_HB = 176 * MiB;
constexpr size_t WS_PP = 208 * MiB;
constexpr size_t WS_Y = 176 * MiB;
constexpr size_t WS_BIG = 240 * MiB;
constexpr size_t WS_Z = WS_BIG;
constexpr size_t WS_AO = WS_BIG + 96 * MiB;
constexpr size_t WS_AT = WS_BIG + 128 * MiB;
constexpr size_t WS_ACT0 = WS_BIG;
constexpr size_t WS_UV = WS_BIG;
constexpr size_t WS_SG = WS_BIG + 64 * MiB;
constexpr size_t WS_ACTM = WS_BIG;
constexpr size_t WS_HB2 = WS_BIG;
constexpr size_t WS_HB3 = WS_BIG + 96 * MiB;
constexpr size_t WS_PP2 = WS_BIG + 32 * MiB;
constexpr size_t WS_PB1 = 418 * MiB;
constexpr size_t WS_END = 426 * MiB;
static_assert(WS_WEND <= WS_HB, "weights fit below HB");
static_assert(WS_ACTM + (size_t)(32768 + 256) * DFF * 2 <= WS_PB1, "ACTM fits");
constexpr int CW_BAR = 4096;
constexpr int CW_CNT = 8192;

__device__ __forceinline__ int fresh_lane() { int x; asm volatile("v_mbcnt_lo_u32_b32 %0, -1, 0\n\tv_mbcnt_hi_u32_b32 %0, -1, %0" : "=v"(x)); return x; }
__device__ __forceinline__ float bf2f(bf16 b) { return __builtin_bit_cast(float, (unsigned)b << 16); }
__device__ __forceinline__ float bflo(unsigned w) { return __builtin_bit_cast(float, w << 16); }
__device__ __forceinline__ float bfhi(unsigned w) { return __builtin_bit_cast(float, w & 0xffff0000u); }
typedef __bf16 bf16x2_t __attribute__((ext_vector_type(2)));
__device__ __forceinline__ unsigned pk2(float lo, float hi) { f32x2 v = {lo, hi}; bf16x2_t b = __builtin_convertvector(v, bf16x2_t); return __builtin_bit_cast(unsigned, b); }
__device__ __forceinline__ v4u pk8(const float (&v)[8]) { v4u w; w.x = pk2(v[0], v[1]); w.y = pk2(v[2], v[3]); w.z = pk2(v[4], v[5]); w.w = pk2(v[6], v[7]); return w; }
__device__ __forceinline__ void unpk8(v4u w, float (&v)[8]) { v[0] = bflo(w.x); v[1] = bfhi(w.x); v[2] = bflo(w.y); v[3] = bfhi(w.y); v[4] = bflo(w.z); v[5] = bfhi(w.z); v[6] = bflo(w.w); v[7] = bfhi(w.w); }
__device__ __forceinline__ float wave_sum(float v) {
#pragma unroll
    for (int o = 1; o < 64; o <<= 1) v += __shfl_xor(v, o);
    return v;
}
__device__ __forceinline__ float rscale16(const float* ss, int row) {
    const f32x4* p = (const f32x4*)(ss + (size_t)row * 16);
    const f32x4 a = p[0], b = p[1], c = p[2], d = p[3];
    const float s = ((a.x + a.y) + (a.z + a.w)) + ((b.x + b.y) + (b.z + b.w)) + ((c.x + c.y) + (c.z + c.w)) + ((d.x + d.y) + (d.z + d.w));
    return 1.0f / sqrtf(s * (1.0f / DM) + RMS_EPS);
}
__device__ __forceinline__ float sum16(const float* p16) {
    const f32x4* p = (const f32x4*)p16; const f32x4 a = p[0], b = p[1], c = p[2], d = p[3];
    return ((a.x + a.y) + (a.z + a.w)) + ((b.x + b.y) + (b.z + b.w)) + ((c.x + c.y) + (c.z + c.w)) + ((d.x + d.y) + (d.z + d.w));
}
__device__ __forceinline__ float sigmoidf_(float x) { return 1.0f / (1.0f + __expf(-x)); }
__device__ __forceinline__ float siluf_(float x) { return x / (1.0f + __expf(-x)); }
__device__ __forceinline__ float geluf_(float v) {
    const float av = fabsf(v), t = __builtin_amdgcn_rcpf(av * 0.2316418882f + 1.0f);
    float q = t * 0.5307027145f + (-0.7265760135f); q = q * t + 0.7107068705f; q = q * t + (-0.142248368f); q = q * t + 0.127414796f; q = q * t;
    const float e = __builtin_amdgcn_exp2f((v * v) * (-0.72134752044f));
    const float m = v * (q * e);
    return v < 0.f ? m : v - m;
}
namespace pg8 {
constexpr int BM = 256, BK = 64, HALF = 128, HTB = HALF * BK * 2  , STAGE_BYTES = 8 * HTB, NXCD = 8, WGM = 8;

__host__ __device__ __forceinline__ int lds_byte(int r, int c) { const int st = (r >> 4) * 2 + (c >> 5), rr = r & 15, cc = c & 31, ob = rr * 64 + cc * 2; return st * 1024 + (ob ^ (((ob >> 9) & 1) << 5)); }
__host__ __device__ __forceinline__ void stage_rc(int b, int& R, int& C) { const int st = b / 1024, sb = b % 1024, swz = sb ^ (((sb >> 9) & 1) << 5); R = (st >> 1) * 16 + swz / 64; C = (st & 1) * 32 + (swz % 64) / 2; }
__host__ __device__ __forceinline__ int perm32(int rho) { const int n = rho >> 4, i = rho & 15; return 8 * (i >> 2) + 4 * n + (i & 3); }

struct Unit { int row0, col0, e, valid, pos0; };
struct Gemm { const bf16* A; const bf16* Bt; size_t bstride; int K; const int* tok; };

struct StaticOrder {
    int nM, nN, nwg, G, c;
    __device__ void init(int M, int N, int G_, int c_) { nM = M / BM; nN = N / BM; nwg = nM * nN; G = G_; c = c_; }
    __device__ __forceinline__ bool tile(int i, int& pm, int& pn) const {
        const long L = (long)i * G + c; if (L >= nwg) return false;
        int wgid = (int)L; { const int q = nwg / NXCD, r = nwg % NXCD, xcd = wgid % NXCD, off = wgid / NXCD; wgid = (xcd < r ? xcd * (q + 1) : r * (q + 1) + (xcd - r) * q) + off; }
        const int nig = WGM * nN, gid = wgid / nig, fm = gid * WGM, gsz = (nM - fm) < WGM ? (nM - fm) : WGM;
        pm = fm + ((wgid % nig) % gsz); pn = (wgid % nig) / gsz; return true;
    }
    __device__ __forceinline__ bool next(int i, Unit& u) const { int pm, pn; if (!tile(i, pm, pn)) return false; u.row0 = pm * BM; u.col0 = pn * BM; u.e = 0; u.valid = BM; u.pos0 = 0; return true; }
};
struct MoeOrder {
    StaticOrder so; const LAS int* tab;
    __device__ void init(const LAS int* tab_, int N, int G_, int c_) { tab = tab_; so.nM = tab_[8]; so.nN = N / BM; so.nwg = so.nM * so.nN; so.G = G_; so.c = c_; }
    __device__ __forceinline__ bool next(int i, Unit& u) const {
        int gm, pn; if (!so.tile(i, gm, pn)) return false;
        int e = 0;
#pragma unroll
        for (int k = 1; k < 8; ++k) e += (gm >= tab[k]) ? 1 : 0;
        const int j = gm - tab[e], cnt = tab[18 + e];
        u.e = e; u.pos0 = j * BM; u.row0 = tab[9 + e] + j * BM; u.col0 = pn * BM; u.valid = (cnt - j * BM) < BM ? (cnt - j * BM) : BM; return true;
    }
};

template <class Epi, class Sched, bool GATHER, bool ALIGN_EPI>
__device__ __forceinline__ void gemm_phase(LAS unsigned char* lds, const int wid, const Gemm g, const Sched& S, const Epi& E) {
    const int lane = fresh_lane(), tid = (wid << 6) | lane, wr = wid >> 2, wc = wid & 3, fr = lane & 15, fq = lane >> 4;
    const int K = g.K, nt = K / BK;
    int RA[2], CA[2]; unsigned voffB[2];
#pragma unroll
    for (int i = 0; i < 2; ++i) { int R, C; stage_rc(tid * 16 + i * 8192, R, C); const int Rb = (R & ~31) + perm32(R & 31); RA[i] = R; CA[i] = C; voffB[i] = (unsigned)(Rb * K + C) * 2u; }
    const size_t kstep = (size_t)(BK * 2);
    const size_t hstep = (size_t)HALF * K * 2;
    const unsigned ldsw = (unsigned)wid * 1024u;
    const int aoff = lds_byte(wr * 64 + fr, fq * 8), boff = lds_byte(wc * 32 + fr, fq * 8);
#define PG8_SA(b, h) (((b) * 2 + (h)) * HTB)
#define PG8_SB(b, h) ((4 + (b) * 2 + (h)) * HTB)
#define PG8_STAGE2(bufoff, gbase, o0, o1) do { \
        __builtin_amdgcn_global_load_lds((const unsigned*)((const char*)(gbase) + (o0)), (LAS unsigned*)(lds + (bufoff) + ldsw), 16, 0, 0); \
        __builtin_amdgcn_global_load_lds((const unsigned*)((const char*)(gbase) + (o1)), (LAS unsigned*)(lds + (bufoff) + ldsw + 8192), 16, 0, 0); } while (0)
#define PG8_STB(bufoff, gbase) PG8_STAGE2(bufoff, gbase, voffB[0], voffB[1])
#define PG8_STA(bufoff, gbase, OFF, h) PG8_STAGE2(bufoff, gbase, OFF[h][0], OFF[h][1])
#define PG8_LDA(dst, b, h) do { _Pragma("unroll") for (int m = 0; m < 4; ++m) _Pragma("unroll") for (int k = 0; k < 2; ++k) dst[m][k] = *(const LAS bf16x8*)(lds + PG8_SA(b, h) + aoff + m * 2048 + k * 1024); } while (0)
#define PG8_LDB(dst, b, h) do { _Pragma("unroll") for (int n = 0; n < 2; ++n) _Pragma("unroll") for (int k = 0; k < 2; ++k) dst[n][k] = *(const LAS bf16x8*)(lds + PG8_SB(b, h) + boff + n * 2048 + k * 1024); } while (0)
#define PG8_MMA(ai, bj, At, Bt) do { __builtin_amdgcn_s_setprio(1); _Pragma("unroll") for (int m = 0; m < 4; ++m) _Pragma("unroll") for (int n = 0; n < 2; ++n) _Pragma("unroll") for (int k = 0; k < 2; ++k) \
        acc[ai][bj][m][n] = __builtin_amdgcn_mfma_f32_16x16x32_bf16(Bt[n][k], At[m][k], acc[ai][bj][m][n], 0, 0, 0); __builtin_amdgcn_s_setprio(0); } while (0)
#define PG8_WAIT_V(n) asm volatile("s_waitcnt vmcnt(" #n ")" ::: "memory")
#define PG8_WAIT_L(n) asm volatile("s_waitcnt lgkmcnt(" #n ")" ::: "memory")
#define PG8_BAR __builtin_amdgcn_s_barrier()
#define PG8_SCHED __builtin_amdgcn_sched_barrier(0)
#define PG8_AOFF(OFF, u) do { _Pragma("unroll") for (int h_ = 0; h_ < 2; ++h_) _Pragma("unroll") for (int i_ = 0; i_ < 2; ++i_) { \
        if constexpr (GATHER) { const int r_ = h_ * HALF + RA[i_]; const int t_ = (r_ < (u).valid) ? g.tok[(u).e * NTOK + (u).pos0 + r_] : 0; OFF[h_][i_] = (unsigned)(t_ * K + CA[i_]) * 2u; } \
        else OFF[h_][i_] = (unsigned)((h_ * HALF + RA[i_]) * K + CA[i_]) * 2u; } } while (0)
    Unit cur, nxt; int ui = 0;
    if (!S.next(0, cur)) return;
    f32x4 acc[2][2][4][2];
#pragma unroll
    for (int a = 0; a < 2; ++a)
#pragma unroll
        for (int b = 0; b < 2; ++b)
#pragma unroll
            for (int m = 0; m < 4; ++m)
#pragma unroll
                for (int n = 0; n < 2; ++n) acc[a][b][m][n] = (f32x4){0.f, 0.f, 0.f, 0.f};
    bf16x8 At[4][2], B0[2][2], B1[2][2];
    unsigned coff[2][2], noff[2][2];
    PG8_AOFF(coff, cur);
    const char* cA = (const char*)g.A + (GATHER ? (size_t)0 : (size_t)cur.row0 * K * 2);
    const char* cB = (const char*)g.Bt + ((size_t)cur.e * g.bstride + (size_t)cur.col0 * K) * 2;
    PG8_STB(PG8_SB(0, 0), cB); PG8_STB(PG8_SB(0, 1), cB + hstep); PG8_STA(PG8_SA(0, 0), cA, coff, 0); PG8_STA(PG8_SA(0, 1), cA, coff, 1);
    if (wr == 1) PG8_BAR;
    PG8_WAIT_V(2); PG8_BAR;
    PG8_STB(PG8_SB(1, 0), cB + kstep); PG8_STA(PG8_SA(1, 0), cA + kstep, coff, 0); PG8_STB(PG8_SB(1, 1), cB + hstep + kstep);
    PG8_WAIT_V(6); PG8_BAR;
    for (;;) {
        const bool has_next = S.next(ui + 1, nxt);
        const char* nA = cA; const char* nB = cB;
        if (has_next) { nA = (const char*)g.A + (GATHER ? (size_t)0 : (size_t)nxt.row0 * K * 2); nB = (const char*)g.Bt + ((size_t)nxt.e * g.bstride + (size_t)nxt.col0 * K) * 2; PG8_AOFF(noff, nxt); }
        else {
#pragma unroll
            for (int h_ = 0; h_ < 2; ++h_)
#pragma unroll
                for (int i_ = 0; i_ < 2; ++i_) noff[h_][i_] = coff[h_][i_];
        }
        for (int t = 0; t < nt; t += 2) {
            const bool last = (t == nt - 2);
            const char* a1 = cA + (size_t)(t + 1) * kstep;
            const char* a2 = last ? nA : cA + (size_t)(t + 2) * kstep; const char* b2 = last ? nB : cB + (size_t)(t + 2) * kstep;
            const char* a3 = a2 + kstep; const char* b3 = b2 + kstep;
            unsigned o2[2][2];
#pragma unroll
            for (int h_ = 0; h_ < 2; ++h_)
#pragma unroll
                for (int i_ = 0; i_ < 2; ++i_) o2[h_][i_] = (GATHER && last) ? noff[h_][i_] : coff[h_][i_];
            PG8_LDB(B0, 0, 0); PG8_LDB(B1, 0, 1); PG8_SCHED; PG8_LDA(At, 0, 0); PG8_STA(PG8_SA(1, 1), a1, coff, 1);
            PG8_WAIT_V(8); PG8_WAIT_L(0); PG8_BAR; PG8_MMA(0, 0, At, B0); PG8_MMA(0, 1, At, B1); PG8_BAR; PG8_SCHED;
            PG8_LDA(At, 0, 1); PG8_STB(PG8_SB(0, 0), b2); PG8_STB(PG8_SB(0, 1), b2 + hstep); PG8_STA(PG8_SA(0, 0), a2, o2, 0);
            PG8_WAIT_V(8); PG8_WAIT_L(0); PG8_BAR; PG8_MMA(1, 0, At, B0); PG8_MMA(1, 1, At, B1); PG8_BAR; PG8_SCHED;
            PG8_LDB(B0, 1, 0); PG8_LDB(B1, 1, 1); PG8_SCHED; PG8_LDA(At, 1, 0); PG8_STA(PG8_SA(0, 1), a2, o2, 1);
            PG8_WAIT_V(8); PG8_WAIT_L(0); PG8_BAR; PG8_MMA(0, 0, At, B0); PG8_MMA(0, 1, At, B1); PG8_BAR; PG8_SCHED;
            PG8_LDA(At, 1, 1); PG8_STB(PG8_SB(1, 0), b3); PG8_STB(PG8_SB(1, 1), b3 + hstep); PG8_STA(PG8_SA(1, 0), a3, o2, 0);
            PG8_WAIT_V(8); PG8_WAIT_L(0); PG8_BAR; PG8_MMA(1, 0, At, B0); PG8_MMA(1, 1, At, B1); PG8_BAR; PG8_SCHED;
        }
        if constexpr (ALIGN_EPI) { if (wr == 0) PG8_BAR; }
        E(acc, cur, wr, wc, fr, fq);
        if (!has_next) break;
#pragma unroll
        for (int a = 0; a < 2; ++a)
#pragma unroll
            for (int b = 0; b < 2; ++b)
#pragma unroll
                for (int m = 0; m < 4; ++m)
#pragma unroll
                    for (int n = 0; n < 2; ++n) acc[a][b][m][n] = (f32x4){0.f, 0.f, 0.f, 0.f};
        cur = nxt; cA = nA; cB = nB; ++ui;
#pragma unroll
        for (int h_ = 0; h_ < 2; ++h_)
#pragma unroll
            for (int i_ = 0; i_ < 2; ++i_) coff[h_][i_] = noff[h_][i_];
        if constexpr (ALIGN_EPI) { if (wr == 1) PG8_BAR; }
    }
    PG8_WAIT_V(0);
    if constexpr (!ALIGN_EPI) { if (wr == 0) PG8_BAR; }
    PG8_BAR;
#undef PG8_SA
#undef PG8_SB
#undef PG8_STAGE2
#undef PG8_STB
#undef PG8_STA
#undef PG8_LDA
#undef PG8_LDB
#undef PG8_MMA
#undef PG8_WAIT_V
#undef PG8_WAIT_L
#undef PG8_BAR
#undef PG8_SCHED
#undef PG8_AOFF
}

template <class Epi, class Sched>
__device__ __forceinline__ void naive_gemm_phase(LAS unsigned char* lds, const int wid, const Gemm g, const Sched& S, const Epi& E) {
    LAS float* As = (LAS float*)lds; LAS float* Bs = As + 64 * 36;
    const int tid = (wid << 6) | fresh_lane(), r = tid >> 3, c8 = (tid & 7) * 8, K = g.K, lr4 = tid >> 3, kq = (tid & 7) * 4;
    Unit u;
    for (int i = 0; S.next(i, u); ++i) {
        const bf16* Bt = g.Bt + (size_t)u.e * g.bstride + (size_t)u.col0 * K;
        for (int sub = 0; sub < 16; ++sub) {
            const int sr = (sub >> 2) * 64, sc = (sub & 3) * 64;
            float acc[8], pacc[8];
#pragma unroll
            for (int j = 0; j < 8; ++j) { acc[j] = 0.f; pacc[j] = 0.f; }
            const bool need_p = E.needs_partner(u, sc + c8);
            const int ur = sr + lr4;
            long arow;
            if (g.tok) arow = (ur < u.valid) ? (long)g.tok[u.e * NTOK + u.pos0 + ur] : 0; else arow = (long)u.row0 + ur;
            const bf16* ap = g.A + (size_t)arow * K + kq; const bf16* bp = Bt + (size_t)(sc + lr4) * K + kq;
            for (int k0 = 0; k0 < K; k0 += 32) {
                __syncthreads();
                { const v2u a = *(const v2u*)(ap + k0), b = *(const v2u*)(bp + k0);
                  LAS float* ad = As + lr4 * 36 + kq; LAS float* bd = Bs + lr4 * 36 + kq;
                  ad[0] = bflo(a.x); ad[1] = bfhi(a.x); ad[2] = bflo(a.y); ad[3] = bfhi(a.y);
                  bd[0] = bflo(b.x); bd[1] = bfhi(b.x); bd[2] = bflo(b.y); bd[3] = bfhi(b.y); }
                __syncthreads();
#pragma unroll 1
                for (int kk = 0; kk < 32; kk += 4) {
                    const f32x4 a4 = *(const LAS f32x4*)(As + r * 36 + kk);
#pragma unroll
                    for (int j = 0; j < 8; ++j) { const f32x4 b4 = *(const LAS f32x4*)(Bs + (c8 + j) * 36 + kk); acc[j] += (a4.x * b4.x + a4.y * b4.y) + (a4.z * b4.z + a4.w * b4.w); }
                    if (need_p) {
#pragma unroll
                        for (int j = 0; j < 8; ++j) { const f32x4 b4 = *(const LAS f32x4*)(Bs + ((c8 ^ 8) + j) * 36 + kk); pacc[j] += (a4.x * b4.x + a4.y * b4.y) + (a4.z * b4.z + a4.w * b4.w); }
                    }
                }
            }
            E.naive(u, sr + r, sc + c8, acc, pacc);
        }
    }
    __syncthreads();
}
}
namespace epi {
using pg8::Unit; using pg8::HALF;
#define EPI_ROWS_BEGIN _Pragma("unroll") for (int ai = 0; ai < 2; ++ai) _Pragma("unroll") for (int m = 0; m < 4; ++m) { const int lr = ai * HALF + wr * 64 + m * 16 + fr;
#define EPI_ROWS_END }
#define EPI_V8(v, ai, bj, m) float v[8]; { const f32x4 a_ = acc[ai][bj][m][0], b_ = acc[ai][bj][m][1]; v[0] = a_[0]; v[1] = a_[1]; v[2] = a_[2]; v[3] = a_[3]; v[4] = b_[0]; v[5] = b_[1]; v[6] = b_[2]; v[7] = b_[3]; }
typedef f32x4 AccT[2][2][4][2];

struct EpiZ {
    bf16* Z; const float* ss; const float* tab;
    __device__ __forceinline__ void group(int row, int col, float (&v)[8], const float (&pv)[8]) const {
        if (col < 1024) {
            const int d = col & 63;
            if (d < 16) {
                const f32x4* t = (const f32x4*)(tab + (size_t)row * 16);
                const f32x4 c0 = t[0], c1 = t[1], s0 = t[2], s1 = t[3];
                const float cs[8] = {c0[0], c0[1], c0[2], c0[3], c1[0], c1[1], c1[2], c1[3]}, sn[8] = {s0[0], s0[1], s0[2], s0[3], s1[0], s1[1], s1[2], s1[3]};
                if (d < 8) {
#pragma unroll
                    for (int j = 0; j < 8; ++j) v[j] = v[j] * cs[j] - pv[j] * sn[j];
                } else {
#pragma unroll
                    for (int j = 0; j < 8; ++j) v[j] = v[j] * cs[j] + pv[j] * sn[j];
                }
            }
            if (col < 512) {
#pragma unroll
                for (int j = 0; j < 8; ++j) v[j] *= ATT_C2;
            }
        }
        *(v4u*)(Z + (size_t)row * ZW + col) = pk8(v);
    }
    __device__ __forceinline__ void operator()(const AccT& acc, const Unit& u, int wr, int wc, int fr, int fq) const {
        const bool qk = u.col0 < 1024;
        EPI_ROWS_BEGIN
            const int row = u.row0 + lr; const float s = rscale16(ss, row);
#pragma unroll
            for (int bj = 0; bj < 2; ++bj) { EPI_V8(v, ai, bj, m)
                float pv[8];
#pragma unroll
                for (int j = 0; j < 8; ++j) { v[j] *= s; pv[j] = qk ? __shfl_xor(v[j], 16) : 0.f; }
                group(row, u.col0 + bj * HALF + wc * 32 + 8 * fq, v, pv); } EPI_ROWS_END
    }
    __device__ __forceinline__ bool needs_partner(const Unit& u, int lc) const { return u.col0 < 1024 && (lc & 63) < 16; }
    __device__ __forceinline__ void naive(const Unit& u, int lr, int lc, float (&v)[8], float (&pv)[8]) const {
        const int row = u.row0 + lr; const float s = rscale16(ss, row);
#pragma unroll
        for (int j = 0; j < 8; ++j) { v[j] *= s; pv[j] *= s; }
        group(row, u.col0 + lc, v, pv);
    }
};

template <int MODE> struct EpiRes {
    const float* res; float* out; bf16* hb; float* ss_out; const float* ss_in; const bf16* pp;
    __device__ __forceinline__ float group(int row, int col, float s, const float (&v)[8]) const {
        const size_t off = (size_t)row * DM + col;
        const f32x4 r0 = *(const f32x4*)(res + off), r1 = *(const f32x4*)(res + off + 4);
        float o[8] = {r0[0], r0[1], r0[2], r0[3], r1[0], r1[1], r1[2], r1[3]};
        if (MODE == 2) {
            float pv[8]; unpk8(*(const v4u*)(pp + off), pv);
#pragma unroll
            for (int j = 0; j < 8; ++j) o[j] += sigmoidf_(s * v[j]) * pv[j];
        } else {
#pragma unroll
            for (int j = 0; j < 8; ++j) o[j] += v[j];
        }
        *(f32x4*)(out + off) = (f32x4){o[0], o[1], o[2], o[3]}; *(f32x4*)(out + off + 4) = (f32x4){o[4], o[5], o[6], o[7]};
        *(v4u*)(hb + off) = pk8(o);
        float q = 0.f;
#pragma unroll
        for (int j = 0; j < 8; ++j) q += o[j] * o[j];
        return q;
    }
    __device__ __forceinline__ void operator()(const AccT& acc, const Unit& u, int wr, int wc, int fr, int fq) const {
        EPI_ROWS_BEGIN
            const int row = u.row0 + lr; const float s = (MODE == 2) ? rscale16(ss_in, row) : 1.f; float q = 0.f;
#pragma unroll
            for (int bj = 0; bj < 2; ++bj) { EPI_V8(v, ai, bj, m) q += group(row, u.col0 + bj * HALF + wc * 32 + 8 * fq, s, v); }
            q += __shfl_xor(q, 16); q += __shfl_xor(q, 32);
            if (fq == 0) ss_out[(size_t)row * 16 + (u.col0 >> 8) * 4 + wc] = q; EPI_ROWS_END
    }
    __device__ __forceinline__ bool needs_partner(const Unit&, int) const { return false; }
    __device__ __forceinline__ void naive(const Unit& u, int lr, int lc, float (&v)[8], float (&)[8]) const {
        const int row = u.row0 + lr; const float s = (MODE == 2) ? rscale16(ss_in, row) : 1.f;
        (void)group(row, u.col0 + lc, s, v);
    }
};

template <bool MOE> struct EpiGlu {
    bf16* act; const float* ss;
    __device__ __forceinline__ void group(size_t orow, int col, float s, const float (&v)[8]) const {
        float o[4];
#pragma unroll
        for (int j = 0; j < 4; ++j) o[j] = siluf_(s * v[j]) * (s * v[4 + j]);
        v2u w; w.x = pk2(o[0], o[1]); w.y = pk2(o[2], o[3]);
        *(v2u*)(act + orow * DFF + (col >> 1)) = w;
    }
    __device__ __forceinline__ void operator()(const AccT& acc, const Unit& u, int wr, int wc, int fr, int fq) const {
        EPI_ROWS_BEGIN
            if (!MOE || lr < u.valid) {
                const int row = u.row0 + lr; const float s = MOE ? ss[u.e * NTOK + u.pos0 + lr] : rscale16(ss, row);
#pragma unroll
                for (int bj = 0; bj < 2; ++bj) { EPI_V8(v, ai, bj, m) group((size_t)row, u.col0 + bj * HALF + wc * 32 + 8 * fq, s, v); }
            } EPI_ROWS_END
    }
    __device__ __forceinline__ bool needs_partner(const Unit&, int) const { return false; }
    __device__ __forceinline__ void naive(const Unit& u, int lr, int lc, float (&v)[8], float (&)[8]) const {
        if (MOE && lr >= u.valid) return;
        const int row = u.row0 + lr; const float s = MOE ? ss[u.e * NTOK + u.pos0 + lr] : rscale16(ss, row);
        group((size_t)row, u.col0 + lc, s, v);
    }
};

struct EpiGelu {
    bf16* UV; const float* ss; float* lns; float* lnq;
    __device__ __forceinline__ void group(int row, int col, float s, float (&v)[8], float& sum, float& sq) const {
#pragma unroll
        for (int j = 0; j < 8; ++j) { v[j] = geluf_(s * v[j]); sum += v[j]; sq += v[j] * v[j]; }
        *(v4u*)(UV + (size_t)row * 2048 + col) = pk8(v);
    }
    __device__ __forceinline__ void operator()(const AccT& acc, const Unit& u, int wr, int wc, int fr, int fq) const {
        const bool vh = u.col0 >= 1024;
        EPI_ROWS_BEGIN
            const int row = u.row0 + lr; const float s = rscale16(ss, row); float sum = 0.f, sq = 0.f;
#pragma unroll
            for (int bj = 0; bj < 2; ++bj) { EPI_V8(v, ai, bj, m) group(row, u.col0 + bj * HALF + wc * 32 + 8 * fq, s, v, sum, sq); }
            if (vh) { sum += __shfl_xor(sum, 16); sum += __shfl_xor(sum, 32); sq += __shfl_xor(sq, 16); sq += __shfl_xor(sq, 32);
                if (fq == 0) { const size_t o = (size_t)row * 16 + ((u.col0 - 1024) >> 8) * 4 + wc; lns[o] = sum; lnq[o] = sq; } } EPI_ROWS_END
    }
    __device__ __forceinline__ bool needs_partner(const Unit&, int) const { return false; }
    __device__ __forceinline__ void naive(const Unit& u, int lr, int lc, float (&v)[8], float (&)[8]) const {
        const int row = u.row0 + lr; const float s = rscale16(ss, row); float sum = 0.f, sq = 0.f;
        group(row, u.col0 + lc, s, v, sum, sq);
    }
};

template <bool MOE> struct EpiStore {
    bf16* O; const float* gate;
    __device__ __forceinline__ void group(size_t orow, int col, float s, float (&v)[8]) const {
#pragma unroll
        for (int j = 0; j < 8; ++j) v[j] *= s;
        *(v4u*)(O + orow * DM + col) = pk8(v);
    }
    __device__ __forceinline__ void operator()(const AccT& acc, const Unit& u, int wr, int wc, int fr, int fq) const {
        EPI_ROWS_BEGIN
            if (!MOE || lr < u.valid) {
                const float s = MOE ? gate[u.e * NTOK + u.pos0 + lr] : 1.f;
#pragma unroll
                for (int bj = 0; bj < 2; ++bj) { EPI_V8(v, ai, bj, m) group((size_t)(u.row0 + lr), u.col0 + bj * HALF + wc * 32 + 8 * fq, s, v); }
            } EPI_ROWS_END
    }
    __device__ __forceinline__ bool needs_partner(const Unit&, int) const { return false; }
    __device__ __forceinline__ void naive(const Unit& u, int lr, int lc, float (&v)[8], float (&)[8]) const {
        if (MOE && lr >= u.valid) return;
        const float s = MOE ? gate[u.e * NTOK + u.pos0 + lr] : 1.f;
        group((size_t)(u.row0 + lr), u.col0 + lc, s, v);
    }
};
#undef EPI_ROWS_BEGIN
#undef EPI_ROWS_END
#undef EPI_V8
}
namespace attn_body {
using bf16=__hip_bfloat16;
using bf16x8=__attribute__((ext_vector_type(8)))short;
using s16x4=__attribute__((ext_vector_type(4)))short;
using f32x16=__attribute__((ext_vector_type(16)))float;
using u32x4=__attribute__((ext_vector_type(4)))unsigned;
constexpr int SEQ=4096,D=64,PIN=3072,POUT=1024;
constexpr int NW=8,QBLK=32,QB=QBLK*NW,KVBLK=64,NQB=SEQ/QB;
constexpr int ATTN_UNIT_ROWS=QB;
__device__ __forceinline__ int crow(int r,int hi){return (r&3)+8*(r>>2)+4*hi;}
#define SBAR() __builtin_amdgcn_sched_barrier(0)
__device__ __forceinline__ void cmask(f32x16&p0,f32x16&p1,int jb,int qrel,int hi){
  const float NEG=-INFINITY; int kb=64*jb+4*hi;
  #pragma unroll
  for(int r=0;r<16;++r){int kv=kb+(r&3)+8*(r>>2); if(kv>qrel)p0[r]=NEG; if(kv+32>qrel)p1[r]=NEG;}
}

constexpr int NSLOT=3, SLOTB=8192;
constexpr int LDS_K=0, LDS_V=NSLOT*SLOTB, LDS_WS=2*NSLOT*SLOTB, LDS_OST=LDS_WS+NW*64*4, LDS_BYTES=LDS_OST+NW*4096;
constexpr float C2=0.125f*1.4426950408889634f;
__device__ __forceinline__ void glds16(const void*gsrc,unsigned lds_dst){unsigned keep;
  asm volatile("s_mov_b32 %0, m0\n\ts_mov_b32 m0, %2\n\ts_nop 0\n\tglobal_load_lds_dwordx4 %1, off\n\ts_mov_b32 m0, %0":"=&s"(keep):"v"(gsrc),"s"(lds_dst):"memory");}
__device__ __forceinline__ float max3f(float a,float b,float c){float r;asm("v_max3_f32 %0, %1, %2, %3":"=v"(r):"v"(a),"v"(b),"v"(c));return r;}
__device__ __forceinline__ float max2f(float a,float b){float r;asm("v_max_f32_e32 %0, %1, %2":"=v"(r):"v"(a),"v"(b));return r;}
__device__ __forceinline__ float fadd_s(float a,float b){float r;asm("v_add_f32_e32 %0, %1, %2":"=v"(r):"v"(a),"v"(b));return r;}
__device__ __forceinline__ float fsub_s(float a,float b){float r;asm("v_sub_f32_e32 %0, %1, %2":"=v"(r):"v"(a),"v"(b));return r;}
typedef float f32x2_t __attribute__((ext_vector_type(2))); typedef __bf16 bf16x2_t __attribute__((ext_vector_type(2)));
__device__ __forceinline__ unsigned cvtpk_s(float lo,float hi){f32x2_t v={lo,hi};bf16x2_t b=__builtin_convertvector(v,bf16x2_t);return __builtin_bit_cast(unsigned,b);}
#define WAIT_BAR(N) asm volatile("s_waitcnt vmcnt(" #N ") lgkmcnt(0)\n\ts_barrier":::"memory")

__device__ __forceinline__ void qkt(f32x16&p0,f32x16&p1,const char*Kslot,const bf16x8*qr,const f32x16&negm,int r32,int hi){
  const char*kb=Kslot+hi*1024+r32*16;
  #pragma unroll
  for(int d0=0;d0<4;++d0){
    const bf16x8 b0=*reinterpret_cast<const bf16x8*>(kb+d0*2048);
    const bf16x8 b1=*reinterpret_cast<const bf16x8*>(kb+d0*2048+512);
    if(d0==0){p0=__builtin_amdgcn_mfma_f32_32x32x16_bf16(b0,qr[0],negm,0,0,0);p1=__builtin_amdgcn_mfma_f32_32x32x16_bf16(b1,qr[0],negm,0,0,0);}
    else{p0=__builtin_amdgcn_mfma_f32_32x32x16_bf16(b0,qr[d0],p0,0,0,0);p1=__builtin_amdgcn_mfma_f32_32x32x16_bf16(b1,qr[d0],p1,0,0,0);}}
}
typedef __attribute__((address_space(3))) const char* lds_cptr;
typedef short v4i16_t __attribute__((ext_vector_type(4)));
__device__ __forceinline__ void kload8(bf16x8*kf,lds_cptr kp){
  kf[0]=*(const __attribute__((address_space(3))) bf16x8*)(kp);      kf[1]=*(const __attribute__((address_space(3))) bf16x8*)(kp+512);
  kf[2]=*(const __attribute__((address_space(3))) bf16x8*)(kp+2048); kf[3]=*(const __attribute__((address_space(3))) bf16x8*)(kp+2560);
  kf[4]=*(const __attribute__((address_space(3))) bf16x8*)(kp+4096); kf[5]=*(const __attribute__((address_space(3))) bf16x8*)(kp+4608);
  kf[6]=*(const __attribute__((address_space(3))) bf16x8*)(kp+6144); kf[7]=*(const __attribute__((address_space(3))) bf16x8*)(kp+6656);
}
__device__ __forceinline__ void kload2(bf16x8*kf,lds_cptr kp,int j){ kf[2*j]=*(const __attribute__((address_space(3))) bf16x8*)(kp+j*2048); kf[2*j+1]=*(const __attribute__((address_space(3))) bf16x8*)(kp+j*2048+512); }
__device__ __forceinline__ s16x4 vtr(lds_cptr p){ return __builtin_bit_cast(s16x4,__builtin_amdgcn_ds_read_tr16_b64_v4i16((__attribute__((address_space(3))) v4i16_t*)p)); }
__device__ __forceinline__ float rowmax(const f32x16&p0,const f32x16&p1){
  float a=max3f(p0[0],p0[1],p1[0]),b=max3f(p0[2],p0[3],p1[1]);a=max3f(a,p1[2],p1[3]);
  #pragma unroll
  for(int r=4;r<16;r+=4){a=max3f(a,p0[r],p0[r+1]);b=max3f(b,p0[r+2],p0[r+3]);a=max3f(a,p1[r],p1[r+1]);b=max3f(b,p1[r+2],p1[r+3]);}
  const float m=max2f(a,b);
  auto rr=__builtin_amdgcn_permlane32_swap(__float_as_uint(m),__float_as_uint(m),false,false);
  return max2f(__uint_as_float(rr[0]),__uint_as_float(rr[1]));
}
__device__ __forceinline__ void pv(f32x16*o,int vb,bf16x8 pa0,bf16x8 pa1,bf16x8 pa2,bf16x8 pa3){
  #pragma unroll
  for(int d0=0;d0<2;++d0){s16x4 lo[4],hi[4];
    #pragma unroll
    for(int ks=0;ks<4;++ks){
      asm volatile("ds_read_b64_tr_b16 %0,%1 offset:%c2":"=&v"(lo[ks]):"v"(vb),"i"(d0*4096+ks*1024):"memory");
      asm volatile("ds_read_b64_tr_b16 %0,%1 offset:%c2":"=&v"(hi[ks]):"v"(vb),"i"(d0*4096+ks*1024+512):"memory");}
    asm volatile("s_waitcnt lgkmcnt(0)":::"memory");SBAR();
    #define PK(k) (bf16x8){lo[k][0],lo[k][1],lo[k][2],lo[k][3],hi[k][0],hi[k][1],hi[k][2],hi[k][3]}
    o[d0]=__builtin_amdgcn_mfma_f32_32x32x16_bf16(pa0,PK(0),o[d0],0,0,0);
    o[d0]=__builtin_amdgcn_mfma_f32_32x32x16_bf16(pa1,PK(1),o[d0],0,0,0);
    o[d0]=__builtin_amdgcn_mfma_f32_32x32x16_bf16(pa2,PK(2),o[d0],0,0,0);
    o[d0]=__builtin_amdgcn_mfma_f32_32x32x16_bf16(pa3,PK(3),o[d0],0,0,0);
    #undef PK
  }
}

#ifndef ATTN_STORE16
#define ATTN_STORE16(p,v) (*(u32x4*)(p)=(v))
#endif
template<int THRL> __device__ __forceinline__ void attn_unit(const int wid,int b,int qb,const bf16*Q,const bf16*__restrict__ K,const bf16*__restrict__ V,bf16*O,char*shm){
  const int lane=fresh_lane(),r32=lane&31,hi=lane>>5;
  const long rowbase=(long)b*SEQ; const int q0=qb*QB;
  const bf16*Qw=Q+(rowbase+q0+wid*QBLK)*PIN;
  const bf16*Kh=K+rowbase*PIN,*Vh=V+rowbase*PIN;
  const unsigned lds0=(unsigned)(uintptr_t)shm;
  float*wsf=(float*)(shm+LDS_WS)+wid*64;
  const bf16*ksrc=Kh+(long)lane*PIN+wid*8;
  const bf16*vsrc=Vh+(long)(16*(wid&3)+(lane>>2))*PIN+(wid>>2)*32+(lane&3)*8;
  const unsigned kdst=lds0+LDS_K+wid*1024, vdst=lds0+LDS_V+wid*1024;
  #define DMA_K(t,slot) glds16(ksrc+(long)(t)*KVBLK*PIN,(unsigned)__builtin_amdgcn_readfirstlane(kdst+(slot)))
  #define DMA_V(t,slot) glds16(vsrc+(long)(t)*KVBLK*PIN,(unsigned)__builtin_amdgcn_readfirstlane(vdst+(slot)))
  const int vb0=(int)(lds0+LDS_V)+((lane>>4)&1)*32+(lane&3)*8+(4*hi+((lane&15)>>2))*64;
  const char*Kbase=shm+LDS_K; bf16x8 kf[8];
  const lds_cptr shm3=(lds_cptr)shm; const lds_cptr kp0=shm3+LDS_K+hi*1024+r32*16; const lds_cptr vp0=shm3+LDS_V+((lane>>4)&1)*32+(lane&3)*8+(4*hi+((lane&15)>>2))*64;
  const int NT=(q0+QB)/KVBLK;
  DMA_K(0,0);DMA_V(0,0);DMA_K(1,SLOTB);
  bf16x8 qr[4];
  #pragma unroll
  for(int d0=0;d0<4;++d0)qr[d0]=*reinterpret_cast<const bf16x8*>(&Qw[(long)r32*PIN+d0*16+hi*8]);
  float mhat=0.f,l_reg=0.f;f32x16 o[2];o[0]=f32x16{};o[1]=f32x16{};f32x16 negm=f32x16{};asm volatile("":"+v"(negm));
  const int qrel=wid*QBLK+r32;
  #define CMASK(P0,P1,t) do{int jb_=(t)-(NT-4); if(jb_>=0)cmask(P0,P1,jb_,qrel,hi);}while(0)
  bool resc=false;
  #define START(P0,P1) do{ const float rm=rowmax(P0,P1); resc=false; \
    { const float dl=rm; mhat=fadd_s(mhat,dl); \
      _Pragma("unroll") for(int r=0;r<16;++r){P0[r]=fsub_s(P0[r],dl);P1[r]=fsub_s(P1[r],dl);} \
      _Pragma("unroll") for(int r=0;r<16;++r)negm[r]=-mhat; asm volatile("":"+v"(negm)); } \
    _Pragma("unroll") for(int r=0;r<16;++r)P0[r]=__builtin_amdgcn_exp2f(P0[r]); }while(0)
  #define RESC() do{ if(resc){ asm volatile("s_waitcnt lgkmcnt(0)":::"memory"); \
      _Pragma("unroll") for(int d_=0;d_<2;++d_) _Pragma("unroll") for(int r=0;r<16;++r)o[d_][r]*=wsf[crow(r,hi)]; } }while(0)
  f32x16 pA0,pA1,pB0,pB1;
  int sl_prev=0,sl_cur=0,sl_next=SLOTB;
  #define ROT() do{sl_prev=sl_cur;sl_cur=sl_next;sl_next=(sl_next==(NSLOT-1)*SLOTB)?0:sl_next+SLOTB;}while(0)
  DMA_K(2,2*SLOTB);
  WAIT_BAR(3);
  qkt(pA0,pA1,Kbase,qr,negm,r32,hi);asm volatile("s_nop 15\n\ts_nop 7":"+v"(pA0),"+v"(pA1));CMASK(pA0,pA1,0);
  START(pA0,pA1);
  _Pragma("unroll") for(int r=0;r<16;++r)pA1[r]=__builtin_amdgcn_exp2f(pA1[r]);
  WAIT_BAR(0);
  DMA_K(3,0);DMA_V(1,SLOTB);
  ROT();
  kload8(kf,kp0+sl_cur);
  WAIT_BAR(2);
  s16x4 vlo[8],vhi[8]; u32x4 pw0,pw1,pw2,pw3;
  #define PKW(P,B) cvtpk_s(P[B],P[B+1])
  #define PAF(k) __builtin_bit_cast(bf16x8,pw##k)
  #define VFR(i) (bf16x8){vlo[i][0],vlo[i][1],vlo[i][2],vlo[i][3],vhi[i][0],vhi[i][1],vhi[i][2],vhi[i][3]}
  #define PIN(x) asm volatile("":"+v"(x))
  #define MX3(a,b,c) __builtin_fmaxf(__builtin_fmaxf((a),(b)),(c))
  #define GAPA(MF,A0,A1,A2,A3,W0,W1,PW) do{ MF; sacc+=A0; sacc+=A1; sacc+=A2; sacc+=A3; PIN(sacc); W0; W1; PIN(PW); SBAR(); }while(0)
  #define EX(v) __builtin_amdgcn_exp2f(v)
  #define GAPB(MF,X,B) do{ MF; X[B]=EX(X[B]); X[B+1]=EX(X[B+1]); X[B+2]=EX(X[B+2]); X[B+3]=EX(X[B+3]); PIN(X); SBAR(); }while(0)
  #define VRD(i) do{ vlo[i]=vtr(vp_+(((i)>>2)*4096+((i)&3)*1024)); vhi[i]=vtr(vp_+(((i)>>2)*4096+((i)&3)*1024+512)); }while(0)
  #define KRD(G,j) do{ if(G){ kload2(kf,kp0+sl_next,j); SBAR(); } }while(0)
  #define STEP(C0,C1,P0,P1,t,GK,GV,GL) do{ SBAR(); \
    const lds_cptr vp_=vp0+sl_prev; \
    VRD(0); SBAR(); float sacc=(P0[0]+P0[1]); \
    GAPA(C0=__builtin_amdgcn_mfma_f32_32x32x16_bf16(kf[0],qr[0],negm,0,0,0), P0[2],P0[3],P0[4],P0[5],     pw0[0]=PKW(P0,0), pw0[1]=PKW(P0,2), pw0); \
    VRD(4); SBAR(); GAPA(C1=__builtin_amdgcn_mfma_f32_32x32x16_bf16(kf[1],qr[0],negm,0,0,0), P0[6],P0[7],P0[8],P0[9],     pw0[2]=PKW(P0,4), pw0[3]=PKW(P0,6), pw0); \
    VRD(1); SBAR(); GAPA(C0=__builtin_amdgcn_mfma_f32_32x32x16_bf16(kf[2],qr[1],C0,0,0,0),   P0[10],P0[11],P0[12],P0[13], pw1[0]=PKW(P0,8), pw1[1]=PKW(P0,10), pw1); \
    VRD(5); SBAR(); GAPA(C1=__builtin_amdgcn_mfma_f32_32x32x16_bf16(kf[3],qr[1],C1,0,0,0),   P0[14],P0[15],P1[0],P1[1],   pw1[2]=PKW(P0,12),pw1[3]=PKW(P0,14), pw1); \
    VRD(2); SBAR(); GAPA(C0=__builtin_amdgcn_mfma_f32_32x32x16_bf16(kf[4],qr[2],C0,0,0,0),   P1[2],P1[3],P1[4],P1[5],     pw2[0]=PKW(P1,0), pw2[1]=PKW(P1,2), pw2); \
    VRD(6); SBAR(); GAPA(C1=__builtin_amdgcn_mfma_f32_32x32x16_bf16(kf[5],qr[2],C1,0,0,0),   P1[6],P1[7],P1[8],P1[9],     pw2[2]=PKW(P1,4), pw2[3]=PKW(P1,6), pw2); \
    VRD(3); SBAR(); GAPA(C0=__builtin_amdgcn_mfma_f32_32x32x16_bf16(kf[6],qr[3],C0,0,0,0),   P1[10],P1[11],P1[12],P1[13], pw3[0]=PKW(P1,8), pw3[1]=PKW(P1,10), pw3); \
    VRD(7); SBAR(); GAPA(C1=__builtin_amdgcn_mfma_f32_32x32x16_bf16(kf[7],qr[3],C1,0,0,0),   P1[14],P1[15],0.f,0.f,       pw3[2]=PKW(P1,12),pw3[3]=PKW(P1,14), pw3); \
    l_reg+=sacc; \
    if(GK){DMA_K((t)+3,sl_cur);} if(GV){DMA_V((t)+1,sl_next);} \
    CMASK(C0,C1,t); \
    { float a=MX3(C0[0],C0[1],C1[0]),b=MX3(C0[2],C0[3],C1[1]); a=MX3(a,C1[2],C1[3]); \
      _Pragma("unroll") for(int r=4;r<16;r+=4){a=MX3(a,C0[r],C0[r+1]);b=MX3(b,C0[r+2],C0[r+3]);a=MX3(a,C1[r],C1[r+1]);b=MX3(b,C1[r+2],C1[r+3]);} \
      float rm=__builtin_fmaxf(a,b); { auto rr=__builtin_amdgcn_permlane32_swap(__float_as_uint(rm),__float_as_uint(rm),false,false); rm=__builtin_fmaxf(__uint_as_float(rr[0]),__uint_as_float(rr[1])); } \
      resc=false; \
      if(__builtin_expect(__any(rm>(float)THRL),0)){ const float dl=__builtin_fmaxf(rm,0.f); mhat+=dl; \
        _Pragma("unroll") for(int r=0;r<16;++r){C0[r]-=dl;C1[r]-=dl;} \
        _Pragma("unroll") for(int r=0;r<16;++r)negm[r]=-mhat; asm volatile("":"+v"(negm)); \
        const float f=__builtin_amdgcn_exp2f(-dl); l_reg*=f; if(hi==0)wsf[r32]=f; resc=true; } } \
    SBAR(); \
    GAPB(o[0]=__builtin_amdgcn_mfma_f32_32x32x16_bf16(PAF(0),VFR(0),o[0],0,0,0), C0,0); \
    GAPB(o[1]=__builtin_amdgcn_mfma_f32_32x32x16_bf16(PAF(0),VFR(4),o[1],0,0,0), C0,4); \
    KRD(GL,0); GAPB(o[0]=__builtin_amdgcn_mfma_f32_32x32x16_bf16(PAF(1),VFR(1),o[0],0,0,0), C0,8); \
    KRD(GL,1); GAPB(o[1]=__builtin_amdgcn_mfma_f32_32x32x16_bf16(PAF(1),VFR(5),o[1],0,0,0), C0,12); \
    KRD(GL,2); GAPB(o[0]=__builtin_amdgcn_mfma_f32_32x32x16_bf16(PAF(2),VFR(2),o[0],0,0,0), C1,0); \
    KRD(GL,3); GAPB(o[1]=__builtin_amdgcn_mfma_f32_32x32x16_bf16(PAF(2),VFR(6),o[1],0,0,0), C1,4); \
    GAPB(o[0]=__builtin_amdgcn_mfma_f32_32x32x16_bf16(PAF(3),VFR(3),o[0],0,0,0), C1,8); \
    GAPB(o[1]=__builtin_amdgcn_mfma_f32_32x32x16_bf16(PAF(3),VFR(7),o[1],0,0,0), C1,12); \
    }while(0)
  int t=1;
  #undef CMASK
  #define CMASK(P0,P1,t) do{}while(0)
  for(;t+5<NT;t+=2){
    STEP(pB0,pB1,pA0,pA1,t,true,true,true);     WAIT_BAR(2); RESC(); ROT();
    STEP(pA0,pA1,pB0,pB1,t+1,true,true,true);   WAIT_BAR(2); RESC(); ROT();
  }
  #undef CMASK
  #define CMASK(P0,P1,t) do{int jb_=(t)-(NT-4); if(jb_>=0)cmask(P0,P1,jb_,qrel,hi);}while(0)
  #define ENDW(tt) do{ if((tt)+3<NT){WAIT_BAR(2);} else if((tt)+2<NT){WAIT_BAR(1);} else {WAIT_BAR(0);} }while(0)
  for(;t+1<NT;t+=2){
    STEP(pB0,pB1,pA0,pA1,t,(t+3<NT),(t+1<NT),(t+1<NT));       ENDW(t);   RESC(); ROT();
    STEP(pA0,pA1,pB0,pB1,t+1,(t+4<NT),(t+2<NT),(t+2<NT));     ENDW(t+1); RESC(); ROT();
  }
  STEP(pB0,pB1,pA0,pA1,NT-1,false,false,false); RESC();
  { float sacc=pB0[0]+pB0[1]; _Pragma("unroll") for(int r=2;r<16;++r)sacc+=pB0[r]; _Pragma("unroll") for(int r=0;r<16;++r)sacc+=pB1[r]; l_reg+=sacc;
    pw0=(u32x4){PKW(pB0,0),PKW(pB0,2),PKW(pB0,4),PKW(pB0,6)};pw1=(u32x4){PKW(pB0,8),PKW(pB0,10),PKW(pB0,12),PKW(pB0,14)};pw2=(u32x4){PKW(pB1,0),PKW(pB1,2),PKW(pB1,4),PKW(pB1,6)};pw3=(u32x4){PKW(pB1,8),PKW(pB1,10),PKW(pB1,12),PKW(pB1,14)};
    SBAR(); pv(o,vb0+sl_cur,PAF(0),PAF(1),PAF(2),PAF(3)); }
  #undef PKW
  #undef PAF
  #undef VFR
  #undef PIN
  #undef MX3
  #undef GAPA
  #undef GAPB
  #undef EX
  #undef VRD
  #undef KRD
  #undef STEP
  #undef ENDW
  {auto rr=__builtin_amdgcn_permlane32_swap(__float_as_uint(l_reg),__float_as_uint(l_reg),false,false);l_reg=__uint_as_float(rr[0])+__uint_as_float(rr[1]);}
  if(hi==0)wsf[32+r32]=l_reg;asm volatile("s_waitcnt lgkmcnt(0)":::"memory");
  float rli[16];
  #pragma unroll
  for(int r=0;r<16;++r)rli[r]=__builtin_amdgcn_rcpf(wsf[32+crow(r,hi)]);
  bf16*Ow=O+(rowbase+q0+wid*QBLK)*POUT;
  { bf16*stg=(bf16*)(shm+LDS_OST)+wid*2048;
    #pragma unroll
    for(int r=0;r<16;++r){const int orow=crow(r,hi);
      #pragma unroll
      for(int d0=0;d0<2;++d0)stg[orow*64+d0*32+r32]=__float2bfloat16(o[d0][r]*rli[r]);}
    asm volatile("s_waitcnt lgkmcnt(0)":::"memory");
    #pragma unroll
    for(int i=0;i<4;++i){const int row=i*8+(lane>>3),ch=lane&7; const u32x4 v=*(const u32x4*)(stg+row*64+ch*8); ATTN_STORE16(Ow+(long)row*POUT+ch*8,v);} }
  asm volatile("s_waitcnt lgkmcnt(0)\n\ts_barrier":::"memory");
  #undef DMA_K
  #undef DMA_V
  #undef CMASK
  #undef START
  #undef RESC
  #undef ROT
}
constexpr int ATTN_LDS_BYTES=LDS_BYTES;
struct AttnTensors { const bf16* Z; bf16* O; };
struct AttnUnit { int b; int vh; int qb; };
struct StaticOrder {
  int vcu,G;
  __device__ __forceinline__ explicit StaticOrder(int grid,int block):vcu((grid%8==0)?(block%8)*(grid/8)+block/8:block),G(grid){}
  __device__ __forceinline__ bool next(int i,AttnUnit&u)const{ const int item=(i>>2)*G+vcu; if(item>=256)return false; const int k=i&3; const int s=item&3; const int pr=item>>2; u.b=pr>>4; u.vh=pr&15; u.qb=(k==0)?s:(k==1)?7-s:(k==2)?8+s:15-s; return true; }
};
template<class Sched,int THRL=8> __device__ __forceinline__ void attn_phase(char*lds,const int wid,const AttnTensors&T,const Sched&S){
  AttnUnit u;
  for(int i=0;S.next(i,u);++i){
    const int h=u.vh>>2,c=(u.vh>>1)&1,half=u.vh&1;
    attn_unit<THRL>(wid,u.b,u.qb,T.Z+h*128+c*64,T.Z+512+h*128+c*64,T.Z+1024+h*128+half*64,T.O+u.vh*64,lds); }
}
#undef SBAR
#undef WAIT_BAR
}
constexpr int RING_OFF = 0, RING_BYTES = 131072;
constexpr int LDSCTL_OFF = 139264;
constexpr int MOETAB_OFF = LDSCTL_OFF + 512;
constexpr int LDS_BYTES = 147456;
constexpr int PREP_SCR_BYTES = 8 * 64 * 65 * 4;
static_assert(PREP_SCR_BYTES <= LDSCTL_OFF && MOETAB_OFF + 128 <= LDS_BYTES, "LDS map");

#define XB_TMO      128
#define XB_XCNT(j)  (256  + 64 * (j))
#define XB_XSUB(j)  (1280 + 64 * (j))
#define XB_XGEN(j)  (2304 + 64 * (j))
#define XB_TOP      3328
#define XB_TOPGEN   3392
#define XCD_BAR_WORDS 3456
#define XB_SPIN_CAP (1u << 18)
__device__ __forceinline__ unsigned xb_ld(unsigned* p)              { return __hip_atomic_load(p, __ATOMIC_RELAXED, __HIP_MEMORY_SCOPE_AGENT); }
__device__ __forceinline__ unsigned xb_add(unsigned* p, unsigned v) { return __hip_atomic_fetch_add(p, v, __ATOMIC_RELAXED, __HIP_MEMORY_SCOPE_AGENT); }
__device__ __forceinline__ unsigned xb_xcc_id() { return (unsigned)__builtin_amdgcn_s_getreg((3 << 11) | 20) & 0xFu; }
#define XB_SPIN(cond, bar) do { unsigned _sp = 0; while (cond) { __builtin_amdgcn_s_sleep(1); \
    if ((++_sp & 255u) == 0u) { if (xb_ld(&(bar)[XB_TMO])) break; if (_sp > XB_SPIN_CAP) { atomicAdd(&(bar)[XB_TMO], 1u); break; } } } } while (0)
struct XcdBarrier { unsigned* bar; unsigned x; volatile LAS unsigned* st; int wave; };
__device__ __forceinline__ XcdBarrier xcd_barrier_post(unsigned* bar, volatile LAS unsigned* st, int wave) {
    XcdBarrier b; b.bar = bar; b.x = xb_xcc_id(); b.st = st; b.wave = wave;
    if (wave == 0 && fresh_lane() == 0) (void)xb_add(&bar[XB_XCNT(b.x)], 1u);
    return b;
}
__device__ __forceinline__ void xcd_barrier_complete(unsigned* bar, unsigned x, unsigned& nloc, unsigned& nx) {
    const unsigned G = gridDim.x * gridDim.y * gridDim.z;
    unsigned sum, cnt, mine, sp = 0u;
    for (;;) {
        sum = 0u; cnt = 0u; mine = 0u;
#pragma unroll
        for (unsigned j = 0; j < 16; ++j) { const unsigned c = xb_ld(&bar[XB_XCNT(j)]); sum += c; cnt += (c > 0u) ? 1u : 0u; mine = (j == x) ? c : mine; }
        if (sum == G) break;
        __builtin_amdgcn_s_sleep(1);
        if ((++sp & 255u) == 0u) { if (xb_ld(&bar[XB_TMO])) break; if (sp > XB_SPIN_CAP) { atomicAdd(&bar[XB_TMO], 1u); break; } }
    }
    nloc = mine > 0u ? mine : 1u; nx = cnt > 0u ? cnt : 1u;
}
__device__ __forceinline__ void xcd_barrier(const XcdBarrier& b) {
    asm volatile("s_waitcnt vmcnt(0)" ::: "memory");
    __syncthreads();
    if (b.wave == 0 && fresh_lane() == 0) {
        unsigned* bar = b.bar;
        __builtin_amdgcn_s_waitcnt(0);
        unsigned nloc = b.st[0], nx = b.st[1];
        if (nloc == 0u) { xcd_barrier_complete(bar, b.x, nloc, nx); b.st[0] = nloc; b.st[1] = nx; }
        const unsigned old = xb_add(&bar[XB_XSUB(b.x)], 1u);
        const unsigned gen = old / nloc;
        if (old + 1u == (gen + 1u) * nloc) {
            __builtin_amdgcn_fence(__ATOMIC_RELEASE, "agent");
            asm volatile("s_waitcnt vmcnt(0)" ::: "memory");
            const unsigned og = xb_add(&bar[XB_TOP], 1u);
            const unsigned tg = og / nx;
            if (og + 1u == (tg + 1u) * nx) xb_add(&bar[XB_TOPGEN], 1u);
            else XB_SPIN(xb_ld(&bar[XB_TOPGEN]) == tg, bar);
            __builtin_amdgcn_fence(__ATOMIC_ACQUIRE, "agent");
            xb_add(&bar[XB_XGEN(b.x)], 1u);
            asm volatile("s_waitcnt vmcnt(0)" ::: "memory");
        } else {
            XB_SPIN(xb_ld(&bar[XB_XGEN(b.x)]) == gen, bar);
            __builtin_amdgcn_fence(__ATOMIC_ACQUIRE, "agent");
            asm volatile("s_waitcnt vmcnt(0)" ::: "memory");
        }
    }
    __syncthreads();
}

struct Args { const void* in[27]; float* out; unsigned char* ws; int ph_lo, ph_hi; };
struct Frame {
    LAS unsigned char* lds; gu32* ctl; int wave, vcu, G;
    const Args* a; unsigned char* ws; float* out;
};
#define INF(k) ((const float*)F.a->in[k])
#define WSP(T, off) ((T*)(F.ws + (off)))

struct TrJob { const float* W; const float* W3; const float* g; bf16* Wt; int K, Nsrc, Ndst, nb; size_t sstride, dstride; int gstride; };
__device__ __forceinline__ int tr_items(const TrJob& j) { return j.nb * (j.K / 64) * (j.Ndst / 64); }
__device__ __forceinline__ void tr_item(const TrJob& j, int item, LAS float* scr, int lane) {
    const int per = (j.K / 64) * (j.Ndst / 64), bi = item / per, it = item % per, nblk = j.Ndst / 64, kb = it / nblk, nbk = it % nblk, k0 = 64 * kb, n0 = 64 * nbk;
    const float* W = j.W + (size_t)bi * j.sstride; const float* W3 = j.W3 ? j.W3 + (size_t)bi * j.sstride : nullptr; bf16* Wt = j.Wt + (size_t)bi * j.dstride;
    const float* g = j.g ? j.g + (size_t)bi * j.gstride : nullptr;
    const int c4 = (lane & 15) * 4;
#pragma unroll 4
    for (int i = 0; i < 16; ++i) { const int kk = 4 * i + (lane >> 4);
        const float* src;
        if (W3) { const int g8 = c4 >> 3, half = (c4 >> 2) & 1; src = (half ? W3 : W) + (size_t)(k0 + kk) * j.Nsrc + (n0 >> 1) + g8 * 4; }
        else src = W + (size_t)(k0 + kk) * j.Nsrc + n0 + c4;
        const f32x4 v = *(const f32x4*)src; LAS float* d = scr + kk * 65 + c4; d[0] = v[0]; d[1] = v[1]; d[2] = v[2]; d[3] = v[3]; }
    LDS_WAIT(); asm volatile("" ::: "memory");
    const int c = lane & 7; float gk[8];
#pragma unroll
    for (int q = 0; q < 8; ++q) gk[q] = g ? g[k0 + 8 * c + q] : 1.f;
#pragma unroll
    for (int i = 0; i < 8; ++i) { const int n = 8 * i + (lane >> 3); const LAS float* s = scr + (8 * c) * 65 + n;
        v4u o; o.x = pk2(s[0 * 65] * gk[0], s[1 * 65] * gk[1]); o.y = pk2(s[2 * 65] * gk[2], s[3 * 65] * gk[3]); o.z = pk2(s[4 * 65] * gk[4], s[5 * 65] * gk[5]); o.w = pk2(s[6 * 65] * gk[6], s[7 * 65] * gk[7]);
        *(v4u*)(Wt + (size_t)(n0 + n) * j.K + k0 + 8 * c) = o; }
    LDS_WAIT(); asm volatile("" ::: "memory");
}
__device__ __forceinline__ void p0_prologue(Frame& F) {
    const int lane_ = fresh_lane(), tid_ = (F.wave << 6) | lane_; (void)tid_;
    LAS float* scr = (LAS float*)(F.lds + RING_OFF) + F.wave * (64 * 65);
    const int gw = F.vcu * NWAVES + F.wave, NGW = F.G * NWAVES;
    {
        TrJob J[10];
        J[0] = TrJob{INF(6), nullptr, INF(3), WSP(bf16, WS_WIN0), DM, ZW, ZW, 1, 0, 0, 0};
        J[1] = TrJob{INF(10), nullptr, nullptr, WSP(bf16, WS_WOUT0), DM, DM, DM, 1, 0, 0, 0};
        J[2] = TrJob{INF(11), INF(12), INF(4), WSP(bf16, WS_W13_0), DM, DFF, 2 * DFF, 1, 0, 0, 0};
        J[3] = TrJob{INF(13), nullptr, nullptr, WSP(bf16, WS_W2_0), DFF, DM, DM, 1, 0, 0, 0};
        J[4] = TrJob{INF(14), nullptr, INF(3) + DM, WSP(bf16, WS_WCIN), DM, 2 * DM, 2 * DM, 1, 0, 0, 0};
        J[5] = TrJob{INF(19), nullptr, nullptr, WSP(bf16, WS_WCOUT), DM, DM, DM, 1, 0, 0, 0};
        J[6] = TrJob{INF(24), nullptr, INF(5), WSP(bf16, WS_PLEG), DM, DM, DM, 2, (size_t)DM * DM, (size_t)DM * DM, DM};
        J[7] = TrJob{INF(25), nullptr, nullptr, WSP(bf16, WS_PLEP), PLE, DM, DM, 2, (size_t)PLE * DM, (size_t)PLE * DM, 0};
        J[8] = TrJob{INF(21), INF(22), INF(4) + DM, WSP(bf16, WS_M13), DM, DFF, 2 * DFF, NE, (size_t)DM * DFF, (size_t)2 * DFF * DM, 0};
        J[9] = TrJob{INF(23), nullptr, nullptr, WSP(bf16, WS_M2), DFF, DM, DM, NE, (size_t)DFF * DM, (size_t)DM * DFF, 0};
        int base = 0;
#pragma unroll
        for (int q = 0; q < 10; ++q) { const int n = tr_items(J[q]);
            int first = gw - (base % NGW); if (first < 0) first += NGW;
            for (int it = first; it < n; it += NGW) tr_item(J[q], it, scr, lane_);
            base += n; }
    }
    const float* x = INF(0); bf16* HB = WSP(bf16, WS_HB); float* ssa = WSP(float, WS_SSA); float* tab = WSP(float, WS_TAB);
    const int* pos = (const int*)F.a->in[2];
    for (int m = gw; m < NTOK; m += NGW) {
        const f32x4* xr = (const f32x4*)(x + (size_t)m * DM) + lane_; float q = 0.f; f32x4 v[4];
#pragma unroll
        for (int j = 0; j < 4; ++j) { v[j] = xr[64 * j]; q += (v[j][0] * v[j][0] + v[j][1] * v[j][1]) + (v[j][2] * v[j][2] + v[j][3] * v[j][3]); }
        q = wave_sum(q);
        v2u* o = (v2u*)(HB + (size_t)m * DM) + lane_;
#pragma unroll
        for (int j = 0; j < 4; ++j) { v2u w; w.x = pk2(v[j][0], v[j][1]); w.y = pk2(v[j][2], v[j][3]); o[64 * j] = w; }
        if (lane_ < 16) ssa[(size_t)m * 16 + lane_] = (lane_ == 0) ? q : 0.f;
        if (lane_ < 16) { const int i = lane_ & 7; const float inv = powf(500000.0f, -(float)(2 * i) / 16.0f); const float ang = (float)pos[m] * inv;
            tab[(size_t)m * 16 + lane_] = (lane_ < 8) ? cosf(ang) : sinf(ang); }
    }
    {
        const float* p = INF(1); bf16* pb0 = (bf16*)F.out; bf16* pb1 = WSP(bf16, WS_PB1);
        const long n8 = (long)NTOK * PLE / 8;
        for (long i = (long)gw * 64 + lane_; i < 2 * n8; i += (long)NGW * 64) {
            const f32x4 a = *(const f32x4*)(p + i * 8), b = *(const f32x4*)(p + i * 8 + 4);
            v4u w; w.x = pk2(a[0], a[1]); w.y = pk2(a[2], a[3]); w.z = pk2(b[0], b[1]); w.w = pk2(b[2], b[3]);
            if (i < n8) *(v4u*)(pb0 + i * 8) = w; else *(v4u*)(pb1 + (i - n8) * 8) = w; }
    }
    {
        const float* ws_ = INF(17); bf16* wt = WSP(bf16, WS_WTRIL);
        for (int i = gw * 64 + lane_; i < 8 * 128 * 128; i += NGW * 64) { const int t = (i >> 7) & 127, s = i & 127; wt[i] = (bf16)(pk2(s <= t ? ws_[i] : 0.f, 0.f) & 0xffffu); }
    }
}

__device__ __forceinline__ void mix_phase(Frame& F) {
    const int lane_ = fresh_lane(), tid_ = (F.wave << 6) | lane_; (void)tid_;
    const int gw = F.vcu * NWAVES + F.wave, NGW = F.G * NWAVES, l = lane_;
    const float* lp = INF(7);
    const float s01 = wave_sum(lp[l] * lp[64 + l]), s23 = wave_sum(lp[128 + l] * lp[192 + l]);
    const float lam = expf(s01) - expf(s23) + 0.2f;
    const bf16* AT = WSP(bf16, WS_AT); const bf16* Z = WSP(bf16, WS_Z); bf16* AO = WSP(bf16, WS_AO);
    const float* subln = INF(8); const float* cw = INF(9);
    const int h = l >> 4, e0 = (l & 15) * 8, ch0 = l * 8;
    float sg[8], w0[8], w1[8], w2[8];
#pragma unroll
    for (int j = 0; j < 8; ++j) { sg[j] = subln[e0 + j] * 0.8f; w0[j] = cw[(ch0 + j) * 3 + 0]; w1[j] = cw[(ch0 + j) * 3 + 1]; w2[j] = cw[(ch0 + j) * 3 + 2]; }
    for (int m = gw; m < NTOK; m += NGW) {
        float o1[8], o2[8], a[8]; unpk8(*(const v4u*)(AT + (size_t)m * DM + h * 256 + e0), o1); unpk8(*(const v4u*)(AT + (size_t)m * DM + h * 256 + 128 + e0), o2);
        float q = 0.f;
#pragma unroll
        for (int j = 0; j < 8; ++j) { a[j] = o1[j] - lam * o2[j]; q += a[j] * a[j]; }
        q += __shfl_xor(q, 1); q += __shfl_xor(q, 2); q += __shfl_xor(q, 4); q += __shfl_xor(q, 8);
        const float r = 1.0f / sqrtf(q * (1.0f / 128.0f) + RMS_EPS);
#pragma unroll
        for (int j = 0; j < 8; ++j) a[j] = a[j] * r * sg[j];
        *(v4u*)(AO + (size_t)m * DM + h * 128 + e0) = pk8(a);
        const int t = m & (SEQ - 1);
        float bg[8], cg[8], hc[8], acc[8];
        unpk8(*(const v4u*)(Z + (size_t)m * ZW + 1536 + ch0), bg);
        unpk8(*(const v4u*)(Z + (size_t)m * ZW + 2048 + ch0), cg); unpk8(*(const v4u*)(Z + (size_t)m * ZW + 2560 + ch0), hc);
#pragma unroll
        for (int j = 0; j < 8; ++j) acc[j] = w2[j] * cg[j] * hc[j];
        if (t >= 1) { unpk8(*(const v4u*)(Z + (size_t)(m - 1) * ZW + 2048 + ch0), cg); unpk8(*(const v4u*)(Z + (size_t)(m - 1) * ZW + 2560 + ch0), hc);
#pragma unroll
            for (int j = 0; j < 8; ++j) acc[j] += w1[j] * cg[j] * hc[j]; }
        if (t >= 2) { unpk8(*(const v4u*)(Z + (size_t)(m - 2) * ZW + 2048 + ch0), cg); unpk8(*(const v4u*)(Z + (size_t)(m - 2) * ZW + 2560 + ch0), hc);
#pragma unroll
            for (int j = 0; j < 8; ++j) acc[j] += w0[j] * cg[j] * hc[j]; }
#pragma unroll
        for (int j = 0; j < 8; ++j) acc[j] *= bg[j];
        *(v4u*)(AO + (size_t)m * DM + 512 + ch0) = pk8(acc);
    }
}
__device__ __forceinline__ void stat_ss_phase(Frame& F, float* ss) {
    const int lane_ = fresh_lane(), tid_ = (F.wave << 6) | lane_; (void)tid_;
    const int gw = F.vcu * NWAVES + F.wave, NGW = F.G * NWAVES;
    for (int m = gw; m < NTOK; m += NGW) {
        const f32x4* xr = (const f32x4*)(F.out + (size_t)m * DM) + lane_; float q = 0.f;
#pragma unroll
        for (int j = 0; j < 4; ++j) { const f32x4 v = xr[64 * j]; q += (v[0] * v[0] + v[1] * v[1]) + (v[2] * v[2] + v[3] * v[3]); }
        q = wave_sum(q);
        if (lane_ < 16) ss[(size_t)m * 16 + lane_] = (lane_ == 0) ? q : 0.f;
    }
}
__device__ __forceinline__ void stat_ln_phase(Frame& F) {
    const int lane_ = fresh_lane(), tid_ = (F.wave << 6) | lane_; (void)tid_;
    const int gw = F.vcu * NWAVES + F.wave, NGW = F.G * NWAVES; const bf16* UV = WSP(bf16, WS_UV); float* lns = WSP(float, WS_LNS); float* lnq = WSP(float, WS_LNQ);
    for (int m = gw; m < NTOK; m += NGW) {
        float v[8], a[8]; unpk8(*(const v4u*)(UV + (size_t)m * 2048 + 1024 + lane_ * 8), v); unpk8(*(const v4u*)(UV + (size_t)m * 2048 + 1536 + lane_ * 8), a);
        float s = 0.f, q = 0.f;
#pragma unroll
        for (int j = 0; j < 8; ++j) { s += v[j] + a[j]; q += v[j] * v[j] + a[j] * a[j]; }
        s = wave_sum(s); q = wave_sum(q);
        if (lane_ < 16) { lns[(size_t)m * 16 + lane_] = (lane_ == 0) ? s : 0.f; lnq[(size_t)m * 16 + lane_] = (lane_ == 0) ? q : 0.f; }
    }
}
__device__ __forceinline__ void sgate_naive_phase(Frame& F) {
    const int lane_ = fresh_lane(), tid_ = (F.wave << 6) | lane_; (void)tid_;
    const bf16* UV = WSP(bf16, WS_UV); bf16* SG = WSP(bf16, WS_SG); const float* lns = WSP(float, WS_LNS); const float* lnq = WSP(float, WS_LNQ);
    const float* lg = INF(15); const float* lb = INF(16); const float* W = INF(17); const float* bs = INF(18);
    const long nitem = (long)NTOK * 128;
    for (long it = (long)blockIdx.x * NTHREADS + tid_; it < nitem; it += (long)F.G * NTHREADS) {
        const int row = (int)(it >> 7), c8 = (int)(it & 127) * 8, g = c8 >> 7, tl = row & 127, r0 = row - tl;
        float gg[8], bb[8], acc[8];
#pragma unroll
        for (int j = 0; j < 8; ++j) { gg[j] = lg[c8 + j]; bb[j] = lb[c8 + j]; acc[j] = 0.f; }
        for (int sl = 0; sl <= tl; ++sl) {
            const int rs = r0 + sl; const float mu = sum16(lns + (size_t)rs * 16) * (1.0f / DM), var = sum16(lnq + (size_t)rs * 16) * (1.0f / DM) - mu * mu, rstd = 1.0f / sqrtf(var + LN_EPS);
            float v[8]; unpk8(*(const v4u*)(UV + (size_t)rs * 2048 + 1024 + c8), v);
            const float w = W[(g * 128 + tl) * 128 + sl];
#pragma unroll
            for (int j = 0; j < 8; ++j) acc[j] += w * ((v[j] - mu) * rstd * gg[j] + bb[j]);
        }
        float u[8]; unpk8(*(const v4u*)(UV + (size_t)row * 2048 + c8), u);
        const float b0 = bs[g * 128 + tl];
#pragma unroll
        for (int j = 0; j < 8; ++j) acc[j] = u[j] * (acc[j] + b0);
        *(v4u*)(SG + (size_t)row * DM + c8) = pk8(acc);
    }
}
__device__ __forceinline__ void router_phase(Frame& F) {
    const int lane_ = fresh_lane(), tid_ = (F.wave << 6) | lane_; (void)tid_;
    LAS int* sE = (LAS int*)(F.lds + RING_OFF); LAS float* sG = (LAS float*)(F.lds + RING_OFF + 1024); LAS float* sR = (LAS float*)(F.lds + RING_OFF + 2048);
    const float* ssa = WSP(float, WS_SSA); const float* gw_ = INF(4) + DM; const float* rw = INF(20);
    int* mtok = WSP(int, WS_MTOK); float* mscl = WSP(float, WS_MSCL); float* mgate = WSP(float, WS_MGATE); int* mslot = WSP(int, WS_MSLOT);
    for (int tb = blockIdx.x; tb < NTOK / 64; tb += F.G) {
        for (int i = 0; i < 8; ++i) {
            const int lt = F.wave * 8 + i, row = tb * 64 + lt; const float r = rscale16(ssa, row);
            float lg[8];
#pragma unroll
            for (int e = 0; e < 8; ++e) lg[e] = 0.f;
#pragma unroll
            for (int j = 0; j < 4; ++j) { const int k0 = lane_ * 4 + 256 * j; const f32x4 hv = *(const f32x4*)(F.out + (size_t)row * DM + k0), gv = *(const f32x4*)(gw_ + k0);
#pragma unroll
                for (int q = 0; q < 4; ++q) { const float hn = hv[q] * r * gv[q]; const f32x4 w0 = *(const f32x4*)(rw + (size_t)(k0 + q) * 8), w1 = *(const f32x4*)(rw + (size_t)(k0 + q) * 8 + 4);
                    lg[0] += hn * w0[0]; lg[1] += hn * w0[1]; lg[2] += hn * w0[2]; lg[3] += hn * w0[3]; lg[4] += hn * w1[0]; lg[5] += hn * w1[1]; lg[6] += hn * w1[2]; lg[7] += hn * w1[3]; } }
#pragma unroll
            for (int e = 0; e < 8; ++e) lg[e] = wave_sum(lg[e]);
            if (lane_ == 0) {
                int e0 = 0; float v0 = lg[0];
#pragma unroll
                for (int e = 1; e < 8; ++e) if (lg[e] > v0) { v0 = lg[e]; e0 = e; }
                int e1 = -1; float v1 = -INFINITY;
#pragma unroll
                for (int e = 0; e < 8; ++e) if (e != e0 && lg[e] > v1) { v1 = lg[e]; e1 = e; }
                const float g0 = 1.0f / (1.0f + expf(v1 - v0));
                sE[lt * 2] = e0; sE[lt * 2 + 1] = e1; sG[lt * 2] = g0; sG[lt * 2 + 1] = 1.0f - g0; sR[lt] = r;
            }
        }
        __syncthreads();
        if (tid_ < 8) {
            const int e = tid_; int c = 0;
            for (int q = 0; q < 128; ++q) c += (sE[q] == e) ? 1 : 0;
            if (c > 0) {
                int pos = (int)__hip_atomic_fetch_add((unsigned*)(F.ctl + CW_CNT + 64 * e), (unsigned)c, RLX_AGENT);
                for (int q = 0; q < 128; ++q) if (sE[q] == e) { const int tok = tb * 64 + (q >> 1);
                    mtok[e * NTOK + pos] = tok; mscl[e * NTOK + pos] = sR[q >> 1]; mgate[e * NTOK + pos] = sG[q]; mslot[tok * 2 + (q & 1)] = (e << 16) | pos; ++pos; }
            }
        }
        __syncthreads();
    }
}
__device__ __forceinline__ void moe_tab(Frame& F) {
    const int lane_ = fresh_lane(), tid_ = (F.wave << 6) | lane_; (void)tid_;
    LAS int* tab = (LAS int*)(F.lds + MOETAB_OFF);
    if (tid_ == 0) { int tp = 0, rb = 0;
        for (int e = 0; e < 8; ++e) { const int c = (int)__hip_atomic_load((unsigned*)(F.ctl + CW_CNT + 64 * e), RLX_AGENT); tab[e] = tp; tab[9 + e] = rb; tab[18 + e] = c; tp += (c + 255) >> 8; rb += c; }
        tab[8] = tp; tab[17] = rb; }
    __syncthreads();
}
__device__ __forceinline__ void combine_phase(Frame& F) {
    const int lane_ = fresh_lane(), tid_ = (F.wave << 6) | lane_; (void)tid_;
    const int gw = F.vcu * NWAVES + F.wave, NGW = F.G * NWAVES;
    const LAS int* tab = (const LAS int*)(F.lds + MOETAB_OFF);
    const int* mslot = WSP(int, WS_MSLOT); const bf16* Y = WSP(bf16, WS_Y); bf16* HB2 = WSP(bf16, WS_HB2); float* ssb = WSP(float, WS_SSB);
    for (int m = gw; m < NTOK; m += NGW) {
        const int s0 = mslot[m * 2], s1 = mslot[m * 2 + 1];
        const size_t y0 = (size_t)(tab[9 + (s0 >> 16)] + (s0 & 0xffff)), y1 = (size_t)(tab[9 + (s1 >> 16)] + (s1 & 0xffff));
        float q = 0.f;
#pragma unroll
        for (int j = 0; j < 2; ++j) { const int c = lane_ * 8 + 512 * j; const size_t off = (size_t)m * DM + c;
            const f32x4 h0 = *(const f32x4*)(F.out + off), h1 = *(const f32x4*)(F.out + off + 4);
            float a[8], b[8]; unpk8(*(const v4u*)(Y + y0 * DM + c), a); unpk8(*(const v4u*)(Y + y1 * DM + c), b);
            float o[8] = {h0[0], h0[1], h0[2], h0[3], h1[0], h1[1], h1[2], h1[3]};
#pragma unroll
            for (int k = 0; k < 8; ++k) { o[k] += a[k] + b[k]; q += o[k] * o[k]; }
            *(f32x4*)(F.out + off) = (f32x4){o[0], o[1], o[2], o[3]}; *(f32x4*)(F.out + off + 4) = (f32x4){o[4], o[5], o[6], o[7]};
            *(v4u*)(HB2 + off) = pk8(o); }
        q = wave_sum(q);
        if (lane_ < 16) ssb[(size_t)m * 16 + lane_] = (lane_ == 0) ? q : 0.f;
    }
}
__device__ __forceinline__ void final_phase(Frame& F) {
    const int lane_ = fresh_lane(), tid_ = (F.wave << 6) | lane_; (void)tid_;
    const int gw = F.vcu * NWAVES + F.wave, NGW = F.G * NWAVES; const float* ssa = WSP(float, WS_SSA); const float* fn = INF(26);
    f32x4 g[4];
#pragma unroll
    for (int j = 0; j < 4; ++j) g[j] = *((const f32x4*)fn + lane_ + 64 * j);
    for (int m = gw; m < NTOK; m += NGW) { const float r = rscale16(ssa, m); f32x4* xr = (f32x4*)(F.out + (size_t)m * DM) + lane_;
#pragma unroll
        for (int j = 0; j < 4; ++j) { f32x4 v = xr[64 * j]; v = v * r * g[j]; xr[64 * j] = v; } }
}
__device__ __forceinline__ void attn_naive_phase(Frame& F) {
    const int lane_ = fresh_lane(), tid_ = (F.wave << 6) | lane_; (void)tid_;
    const bf16* Z = WSP(bf16, WS_Z); bf16* AT = WSP(bf16, WS_AT);
    const long nitem = (long)BATCH * 16 * SEQ;
    for (long it = (long)blockIdx.x * NTHREADS + tid_; it < nitem; it += (long)F.G * NTHREADS) {
        const int q = (int)(it % SEQ), bv = (int)(it / SEQ), vh = bv & 15, b = bv >> 4, h = vh >> 2, c = (vh >> 1) & 1, half = vh & 1;
        const size_t row = (size_t)b * SEQ + q;
        float qv[64], o[64];
#pragma unroll
        for (int d = 0; d < 64; d += 8) { float t[8]; unpk8(*(const v4u*)(Z + row * ZW + h * 128 + c * 64 + d), t);
#pragma unroll
            for (int j = 0; j < 8; ++j) { qv[d + j] = t[j]; o[d + j] = 0.f; } }
        float mx = -INFINITY, l = 0.f;
        const bf16* kp = Z + (size_t)b * SEQ * ZW + 512 + h * 128 + c * 64; const bf16* vp = Z + (size_t)b * SEQ * ZW + 1024 + h * 128 + half * 64;
        for (int j = 0; j <= q; ++j) {
            float s = 0.f;
#pragma unroll
            for (int d = 0; d < 64; d += 8) { float t[8]; unpk8(*(const v4u*)(kp + (size_t)j * ZW + d), t);
#pragma unroll
                for (int k = 0; k < 8; ++k) s += qv[d + k] * t[k]; }
            const float mn = fmaxf(mx, s), corr = exp2f(mx - mn), p = exp2f(s - mn); l = l * corr + p; mx = mn;
#pragma unroll
            for (int d = 0; d < 64; d += 8) { float t[8]; unpk8(*(const v4u*)(vp + (size_t)j * ZW + d), t);
#pragma unroll
                for (int k = 0; k < 8; ++k) o[d + k] = o[d + k] * corr + p * t[k]; }
        }
        const float il = 1.0f / l;
#pragma unroll
        for (int d = 0; d < 64; d += 8) { float t[8];
#pragma unroll
            for (int k = 0; k < 8; ++k) t[k] = o[d + k] * il;
            *(v4u*)(AT + row * DM + vh * 64 + d) = pk8(t); }
    }
}
__device__ __forceinline__ void sgate_fast_phase(Frame& F) {
    typedef __attribute__((ext_vector_type(16))) float f32x16; typedef short v4i16_t __attribute__((ext_vector_type(4)));
    const int lane = fresh_lane(), tid = (F.wave << 6) | lane, w = F.wave;
    constexpr int RS = 320, VT_OFF = 0, VT_BYTES = 128 * RS, ST_OFF = VT_BYTES, O_OFF = ST_OFF + 1024, ORS = 132;
    static_assert(O_OFF + 128 * ORS * 4 <= RING_BYTES, "sgate LDS");
    LAS unsigned char* vt = F.lds + RING_OFF + VT_OFF; LAS f32x2* st = (LAS f32x2*)(F.lds + RING_OFF + ST_OFF); LAS float* ot = (LAS float*)(F.lds + RING_OFF + O_OFF);
    const bf16* UV = WSP(bf16, WS_UV); bf16* SG = WSP(bf16, WS_SG); const float* lns = WSP(float, WS_LNS); const float* lnq = WSP(float, WS_LNQ);
    const float* lg = INF(15); const float* lb = INF(16); const float* bs = INF(18); const bf16* wt = WSP(bf16, WS_WTRIL);
    const int tb = w >> 1, cb0 = (w & 1) * 2, r = lane & 31, h = lane >> 5;
    for (int item = F.vcu; item < 256; item += F.G) {
        const int chunk = item >> 1, row0 = chunk * 128;
        __syncthreads();
        if (tid < 128) { const int rs = row0 + tid; const float mu = sum16(lns + (size_t)rs * 16) * (1.0f / DM), var = sum16(lnq + (size_t)rs * 16) * (1.0f / DM) - mu * mu;
            st[tid] = (f32x2){mu, 1.0f / sqrtf(var + LN_EPS)}; }
        for (int gi = 0; gi < 4; ++gi) {
            const int g = (item & 1) * 4 + gi, c0 = g * 128;
            __syncthreads();
#pragma unroll
            for (int i = 0; i < 4; ++i) { const int id = tid + 512 * i, s = id >> 4, cg = (id & 15) * 8;
                float v[8]; unpk8(*(const v4u*)(UV + (size_t)(row0 + s) * 2048 + 1024 + c0 + cg), v);
                const f32x2 ms = st[s]; const f32x4 g0 = *(const f32x4*)(lg + c0 + cg), g1 = *(const f32x4*)(lg + c0 + cg + 4), b0 = *(const f32x4*)(lb + c0 + cg), b1 = *(const f32x4*)(lb + c0 + cg + 4);
                const float gg[8] = {g0[0], g0[1], g0[2], g0[3], g1[0], g1[1], g1[2], g1[3]}, bb[8] = {b0[0], b0[1], b0[2], b0[3], b1[0], b1[1], b1[2], b1[3]};
#pragma unroll
                for (int j = 0; j < 8; ++j) v[j] = (v[j] - ms[0]) * ms[1] * gg[j] + bb[j];
                *(LAS v4u*)(vt + s * RS + cg * 2) = pk8(v); }
            bf16x8 af[8];
#pragma unroll
            for (int ks = 0; ks < 8; ++ks) if (ks < 2 * (tb + 1)) af[ks] = *(const bf16x8*)(wt + ((size_t)g * 128 + tb * 32 + r) * 128 + ks * 16 + h * 8);
            __syncthreads();
            f32x16 acc[2]; acc[0] = f32x16{}; acc[1] = f32x16{};
            const LAS unsigned char* bp = vt + (8 * h + ((lane & 15) >> 2)) * RS + (16 * ((lane >> 4) & 1) + 4 * (lane & 3)) * 2;
#pragma unroll
            for (int ks = 0; ks < 8; ++ks) if (ks < 2 * (tb + 1)) {
#pragma unroll
                for (int cb = 0; cb < 2; ++cb) {
                    const LAS unsigned char* p = bp + ks * 16 * RS + (cb0 + cb) * 64;
                    const v4i16_t lo = __builtin_amdgcn_ds_read_tr16_b64_v4i16((LAS v4i16_t*)p), hi = __builtin_amdgcn_ds_read_tr16_b64_v4i16((LAS v4i16_t*)(p + 4 * RS));
                    const bf16x8 bf = (bf16x8){lo[0], lo[1], lo[2], lo[3], hi[0], hi[1], hi[2], hi[3]};
                    acc[cb] = __builtin_amdgcn_mfma_f32_32x32x16_bf16(af[ks], bf, acc[cb], 0, 0, 0);
                } }
#pragma unroll
            for (int cb = 0; cb < 2; ++cb)
#pragma unroll
                for (int q = 0; q < 16; ++q) ot[(tb * 32 + (q & 3) + 8 * (q >> 2) + 4 * h) * ORS + (cb0 + cb) * 32 + r] = acc[cb][q];
            __syncthreads();
#pragma unroll
            for (int i = 0; i < 4; ++i) { const int id = tid + 512 * i, t = id >> 4, cg = (id & 15) * 8;
                const f32x4 a0 = *(const LAS f32x4*)(ot + t * ORS + cg), a1 = *(const LAS f32x4*)(ot + t * ORS + cg + 4);
                float u[8]; unpk8(*(const v4u*)(UV + (size_t)(row0 + t) * 2048 + c0 + cg), u);
                const float b0 = bs[g * 128 + t];
                const float o[8] = {u[0] * (a0[0] + b0), u[1] * (a0[1] + b0), u[2] * (a0[2] + b0), u[3] * (a0[3] + b0), u[4] * (a1[0] + b0), u[5] * (a1[1] + b0), u[6] * (a1[2] + b0), u[7] * (a1[3] + b0)};
                *(v4u*)(SG + (size_t)(row0 + t) * DM + c0 + cg) = pk8(o); }
        }
    }
    __syncthreads();
}
enum Phase { PH_PREP = 0, PH_Z, PH_ATTN, PH_MIX, PH_OUT, PH_ST1, PH_FUP, PH_FDN, PH_ST2, PH_PLE0, PH_ST3, PH_CIN, PH_ST4, PH_SG, PH_COUT, PH_ST5, PH_ROUTER, PH_MUP, PH_MDN, PH_COMB, PH_PLE1, PH_ST6, PH_FINAL, NPH };
constexpr bool NAIVE_G = (NAIVE_MASK & NV_GEMM) != 0, NAIVE_A = (NAIVE_MASK & NV_ATTN) != 0, NAIVE_S = (NAIVE_MASK & NV_SGATE) != 0;
__host__ __device__ constexpr bool phase_on(int p) { return (p == PH_ST1 || p == PH_ST2 || p == PH_ST3 || p == PH_ST4 || p == PH_ST5 || p == PH_ST6) ? NAIVE_G : true; }

template <class Epi, class Sched, bool GATHER>
__device__ __forceinline__ void run_gemm(Frame& F, const pg8::Gemm& g, const Sched& S, const Epi& E) {
    if constexpr (NAIVE_G) pg8::naive_gemm_phase<Epi, Sched>(F.lds + RING_OFF, F.wave, g, S, E);
    else pg8::gemm_phase<Epi, Sched, GATHER, true>(F.lds + RING_OFF, F.wave, g, S, E);
}

__global__ void __launch_bounds__(NTHREADS, 2) fwd_kernel(Args args) {
    extern __shared__ __attribute__((aligned(16))) unsigned char lds[];
    Frame F;
    F.lds = (LAS unsigned char*)lds; F.a = &args; F.ws = args.ws; F.out = args.out;
    F.wave = __builtin_amdgcn_readfirstlane((int)threadIdx.x >> 6);
    F.G = gridDim.x; { const int bx = blockIdx.x; F.vcu = (F.G % 8 == 0) ? (bx % 8) * (F.G / 8) + bx / 8 : bx; }
    F.ctl = (gu32*)(args.ws + WS_CTL);
    if (F.wave == 0) ((LAS unsigned*)(F.lds + LDSCTL_OFF))[fresh_lane()] = 0u;
    __syncthreads();
    const int lo = args.ph_lo, hi = args.ph_hi;
    XcdBarrier bar; bar.bar = (unsigned*)(F.ctl + CW_BAR); bar.x = 0; bar.st = nullptr; bar.wave = F.wave;
    if (hi - lo > 1) bar = xcd_barrier_post((unsigned*)(F.ctl + CW_BAR), (volatile LAS unsigned*)(F.lds + LDSCTL_OFF) + 8, F.wave);
    const int cid = (int)blockIdx.x;
#define SEAM(k) do { bool more_ = false; for (int p_ = (k) + 1; p_ < hi; ++p_) more_ = more_ || phase_on(p_); if (more_) xcd_barrier(bar); } while (0)
#ifdef ONLY_PHASE
#define IN(k) ((k) == ONLY_PHASE && phase_on(k) && lo <= (k) && (k) < hi)
#else
#define IN(k) (phase_on(k) && lo <= (k) && (k) < hi)
#endif

    if (IN(PH_PREP)) { p0_prologue(F); SEAM(PH_PREP); }

    if (IN(PH_Z)) {
        { pg8::Gemm g{WSP(bf16, WS_HB), WSP(bf16, WS_WIN0), 0, DM, nullptr}; pg8::StaticOrder S; S.init(NTOK, ZW, F.G, cid);
          epi::EpiZ E{WSP(bf16, WS_Z), WSP(float, WS_SSA), WSP(float, WS_TAB)}; run_gemm<epi::EpiZ, pg8::StaticOrder, false>(F, g, S, E); }
        { pg8::Gemm g{(const bf16*)F.out, WSP(bf16, WS_PLEP), 0, PLE, nullptr}; pg8::StaticOrder S; S.init(NTOK, DM, F.G, cid);
          epi::EpiStore<false> E{WSP(bf16, WS_PP), nullptr}; run_gemm<epi::EpiStore<false>, pg8::StaticOrder, false>(F, g, S, E); }
        SEAM(PH_Z);
    }
    if (IN(PH_ATTN)) {
        if constexpr (NAIVE_A) attn_naive_phase(F);
        else { const attn_body::AttnTensors AT{(const attn_body::bf16*)WSP(bf16, WS_Z), (attn_body::bf16*)WSP(bf16, WS_AT)}; const attn_body::StaticOrder S(F.G, cid);
               attn_body::attn_phase<attn_body::StaticOrder>((char*)lds + RING_OFF, F.wave, AT, S); }
        SEAM(PH_ATTN);
    }
    if (IN(PH_MIX)) { mix_phase(F); SEAM(PH_MIX); }
    if (IN(PH_OUT)) {
        pg8::Gemm g{WSP(bf16, WS_AO), WSP(bf16, WS_WOUT0), 0, DM, nullptr}; pg8::StaticOrder S; S.init(NTOK, DM, F.G, cid);
        epi::EpiRes<0> E{INF(0), F.out, WSP(bf16, WS_HB), WSP(float, WS_SSB), nullptr, nullptr}; run_gemm<epi::EpiRes<0>, pg8::StaticOrder, false>(F, g, S, E);
        SEAM(PH_OUT);
    }
    if (IN(PH_ST1)) { stat_ss_phase(F, WSP(float, WS_SSB)); SEAM(PH_ST1); }
    if (IN(PH_FUP)) {
        pg8::Gemm g{WSP(bf16, WS_HB), WSP(bf16, WS_W13_0), 0, DM, nullptr}; pg8::StaticOrder S; S.init(NTOK, 2 * DFF, F.G, cid);
        epi::EpiGlu<false> E{WSP(bf16, WS_ACT0), WSP(float, WS_SSB)}; run_gemm<epi::EpiGlu<false>, pg8::StaticOrder, false>(F, g, S, E);
        SEAM(PH_FUP);
    }
    if (IN(PH_FDN)) {
        pg8::Gemm g{WSP(bf16, WS_ACT0), WSP(bf16, WS_W2_0), 0, DFF, nullptr}; pg8::StaticOrder S; S.init(NTOK, DM, F.G, cid);
        epi::EpiRes<0> E{F.out, F.out, WSP(bf16, WS_HB), WSP(float, WS_SSA), nullptr, nullptr}; run_gemm<epi::EpiRes<0>, pg8::StaticOrder, false>(F, g, S, E);
        SEAM(PH_FDN);
    }
    if (IN(PH_ST2)) { stat_ss_phase(F, WSP(float, WS_SSA)); SEAM(PH_ST2); }
    if (IN(PH_PLE0)) {
        pg8::Gemm g{WSP(bf16, WS_HB), WSP(bf16, WS_PLEG), 0, DM, nullptr}; pg8::StaticOrder S; S.init(NTOK, DM, F.G, cid);
        epi::EpiRes<2> E{F.out, F.out, WSP(bf16, WS_HB3), WSP(float, WS_SSB), WSP(float, WS_SSA), WSP(bf16, WS_PP)}; run_gemm<epi::EpiRes<2>, pg8::StaticOrder, false>(F, g, S, E);
        SEAM(PH_PLE0);
    }
    if (IN(PH_ST3)) { stat_ss_phase(F, WSP(float, WS_SSB)); SEAM(PH_ST3); }
    if (IN(PH_CIN)) {
        pg8::Gemm g{WSP(bf16, WS_HB3), WSP(bf16, WS_WCIN), 0, DM, nullptr}; pg8::StaticOrder S; S.init(NTOK, 2 * DM, F.G, cid);
        epi::EpiGelu E{WSP(bf16, WS_UV), WSP(float, WS_SSB), WSP(float, WS_LNS), WSP(float, WS_LNQ)}; run_gemm<epi::EpiGelu, pg8::StaticOrder, false>(F, g, S, E);
        SEAM(PH_CIN);
    }
    if (IN(PH_ST4)) { stat_ln_phase(F); SEAM(PH_ST4); }
    if (IN(PH_SG)) { if constexpr (NAIVE_S) sgate_naive_phase(F); else sgate_fast_phase(F); SEAM(PH_SG); }
    if (IN(PH_COUT)) {
        pg8::Gemm g{WSP(bf16, WS_SG), WSP(bf16, WS_WCOUT), 0, DM, nullptr}; pg8::StaticOrder S; S.init(NTOK, DM, F.G, cid);
        epi::EpiRes<0> E{F.out, F.out, WSP(bf16, WS_HB), WSP(float, WS_SSA), nullptr, nullptr}; run_gemm<epi::EpiRes<0>, pg8::StaticOrder, false>(F, g, S, E);
        SEAM(PH_COUT);
    }
    if (IN(PH_ST5)) { stat_ss_phase(F, WSP(float, WS_SSA)); SEAM(PH_ST5); }
    if (IN(PH_ROUTER)) { router_phase(F); SEAM(PH_ROUTER); }
    if (IN(PH_MUP)) {
        moe_tab(F);
        pg8::Gemm g{WSP(bf16, WS_HB), WSP(bf16, WS_M13), (size_t)2 * DFF * DM, DM, WSP(int, WS_MTOK)}; pg8::MoeOrder S; S.init((const LAS int*)(F.lds + MOETAB_OFF), 2 * DFF, F.G, cid);
        epi::EpiGlu<true> E{WSP(bf16, WS_ACTM), WSP(float, WS_MSCL)}; run_gemm<epi::EpiGlu<true>, pg8::MoeOrder, true>(F, g, S, E);
        SEAM(PH_MUP);
    }
    if (IN(PH_MDN)) {
        moe_tab(F);
        pg8::Gemm g{WSP(bf16, WS_ACTM), WSP(bf16, WS_M2), (size_t)DM * DFF, DFF, nullptr}; pg8::MoeOrder S; S.init((const LAS int*)(F.lds + MOETAB_OFF), DM, F.G, cid);
        epi::EpiStore<true> E{WSP(bf16, WS_Y), WSP(float, WS_MGATE)}; run_gemm<epi::EpiStore<true>, pg8::MoeOrder, false>(F, g, S, E);
        SEAM(PH_MDN);
    }
    if (IN(PH_COMB)) {
        moe_tab(F);
        combine_phase(F);
        { pg8::Gemm g{WSP(bf16, WS_PB1), WSP(bf16, WS_PLEP) + (size_t)DM * PLE, 0, PLE, nullptr}; pg8::StaticOrder S; S.init(NTOK, DM, F.G, cid);
          epi::EpiStore<false> E{WSP(bf16, WS_PP2), nullptr}; run_gemm<epi::EpiStore<false>, pg8::StaticOrder, false>(F, g, S, E); }
        SEAM(PH_COMB);
    }
    if (IN(PH_PLE1)) {
        pg8::Gemm g{WSP(bf16, WS_HB2), WSP(bf16, WS_PLEG) + (size_t)DM * DM, 0, DM, nullptr}; pg8::StaticOrder S; S.init(NTOK, DM, F.G, cid);
        epi::EpiRes<2> E{F.out, F.out, WSP(bf16, WS_HB), WSP(float, WS_SSA), WSP(float, WS_SSB), WSP(bf16, WS_PP2)}; run_gemm<epi::EpiRes<2>, pg8::StaticOrder, false>(F, g, S, E);
        SEAM(PH_PLE1);
    }
    if (IN(PH_ST6)) { stat_ss_phase(F, WSP(float, WS_SSA)); SEAM(PH_ST6); }
    if (IN(PH_FINAL)) { final_phase(F); }
#undef IN
#undef SEAM
}

extern "C" void kernel_launch(void* const* d_in, const int* in_sizes, int n_in, void* d_out, int out_size, void* d_ws, size_t ws_size, hipStream_t stream) {
    static int grid = 0;
    if (grid == 0) {
        if (n_in != 27 || in_sizes[0] != NTOK * DM || out_size != NTOK * DM || ws_size < WS_END) { fprintf(stderr, "kernel_launch: unexpected problem (n_in %d, in0 %d, out %d, ws %zu < %zu); nothing launched\n", n_in, n_in > 0 ? in_sizes[0] : -1, out_size, ws_size, (size_t)WS_END); grid = -1; return; }
        int dev = 0, cus = 0, per_cu = 0;
        if (hipGetDevice(&dev) != hipSuccess || hipDeviceGetAttribute(&cus, hipDeviceAttributeMultiprocessorCount, dev) != hipSuccess) { grid = -1; return; }
        if (hipFuncSetAttribute((const void*)fwd_kernel, hipFuncAttributeMaxDynamicSharedMemorySize, LDS_BYTES) != hipSuccess) { fprintf(stderr, "kernel_launch: hipFuncSetAttribute failed\n"); grid = -1; return; }
        if (hipOccupancyMaxActiveBlocksPerMultiprocessor(&per_cu, (const void*)fwd_kernel, NTHREADS, LDS_BYTES) != hipSuccess || per_cu < 1)
            fprintf(stderr, "kernel_launch: note: occupancy query reports %d workgroups per CU\n", per_cu);
        (void)hipGetLastError();
        grid = cus;
    }
    if (grid < 0) return;
    if (hipMemsetAsync((char*)d_ws + WS_CTL, 0, CTL_ZERO_BYTES, stream) != hipSuccess) return;
    Args a{};
    for (int i = 0; i < 27; ++i) a.in[i] = d_in[i];
    a.out = (float*)d_out; a.ws = (unsigned char*)d_ws;
    if (MK_N_LAUNCHES == 1) { a.ph_lo = 0; a.ph_hi = NPH; hipLaunchKernelGGL(fwd_kernel, dim3(grid), dim3(NTHREADS), LDS_BYTES, stream, a); }
    else for (int p = 0; p < NPH; ++p) { if (!phase_on(p)) continue; a.ph_lo = p; a.ph_hi = p + 1; hipLaunchKernelGGL(fwd_kernel, dim3(grid), dim3(NTHREADS), LDS_BYTES, stream, a); }
}
```
